# Optimizing an MI355X kernel written in HIP

```python
import math
import jax, jax.numpy as jnp
from jax import lax
import numpy as np

D_MODEL = 1024
BATCH = 8
SEQ = 4096
DEPTH = 4

HEAD_DIM = 64
N_MIXERS = 3
SB_HEADS = D_MODEL // HEAD_DIM
FOX_HEADS = D_MODEL // HEAD_DIM
SWA_Q_HEADS = D_MODEL // HEAD_DIM
SWA_KV_HEADS = 4
WINDOW = 128
Q_BLOCK = 128
REL_BUCKETS = 32
REL_MAX_DIST = 128
D_FF = 4 * D_MODEL
PLE_DIM = 256
EPS = 1e-6

kernel_name = "interleaved_sb_fox_swa_hybrid"


def _n_layers_of(kind):
    return len(range(kind, DEPTH, N_MIXERS))


def rms_norm(x, g):
    xf = x.astype(jnp.float32)
    y = xf * lax.rsqrt(jnp.mean(xf * xf, axis=-1, keepdims=True) + EPS)
    return (y * g.astype(jnp.float32)).astype(x.dtype)


def _heads(t, n_heads):
    return t.reshape(t.shape[0], t.shape[1], n_heads, HEAD_DIM)


def stick_breaking_attention(q, k, v):
    B, S, H, Dh = q.shape
    nb = S // Q_BLOCK
    scale = Dh ** -0.5
    qb = q.reshape(B, nb, Q_BLOCK, H, Dh).transpose(1, 0, 2, 3, 4)
    key_pos = jnp.arange(S)

    def block(args):
        q_blk, start = args
        z = jnp.einsum('bqhd,bkhd->bhqk', q_blk, k,
                       preferred_element_type=jnp.float32) * scale
        q_pos = start + jnp.arange(Q_BLOCK)
        strict = key_pos[None, :] < q_pos[:, None]
        log_keep = jnp.where(strict, jax.nn.log_sigmoid(-z), 0.0)
        after = lax.cumsum(log_keep, axis=3, reverse=True) - log_keep
        w = jnp.where(strict, jnp.exp(jax.nn.log_sigmoid(z) + after), 0.0)
        return jnp.einsum('bhqk,bkhd->bqhd', w.astype(v.dtype), v)

    out = lax.map(block, (qb, jnp.arange(nb, dtype=jnp.int32) * Q_BLOCK))
    return out.transpose(1, 0, 2, 3, 4).reshape(B, S, H, Dh)


def forgetting_attention(q, k, v, log_f):
    B, S, H, Dh = q.shape
    nb = S // Q_BLOCK
    scale = Dh ** -0.5
    c = jnp.cumsum(log_f, axis=1).transpose(0, 2, 1)
    cb = c.reshape(B, H, nb, Q_BLOCK).transpose(2, 0, 1, 3)
    qb = q.reshape(B, nb, Q_BLOCK, H, Dh).transpose(1, 0, 2, 3, 4)
    key_pos = jnp.arange(S)

    def block(args):
        q_blk, c_blk, start = args
        s = jnp.einsum('bqhd,bkhd->bhqk', q_blk, k,
                       preferred_element_type=jnp.float32) * scale
        s = s + (c_blk[..., :, None] - c[:, :, None, :])
        q_pos = start + jnp.arange(Q_BLOCK)
        causal = key_pos[None, :] <= q_pos[:, None]
        w = jax.nn.softmax(jnp.where(causal, s, -jnp.inf), axis=-1)
        return jnp.einsum('bhqk,bkhd->bqhd', w.astype(v.dtype), v)

    out = lax.map(block, (qb, cb, jnp.arange(nb, dtype=jnp.int32) * Q_BLOCK))
    return out.transpose(1, 0, 2, 3, 4).reshape(B, S, H, Dh)


def t5_bucket(dist):
    max_exact = REL_BUCKETS // 2
    d = jnp.maximum(dist, 1).astype(jnp.float32)
    large = max_exact + (jnp.log(d / max_exact) / math.log(REL_MAX_DIST / max_exact)
                         * (REL_BUCKETS - max_exact)).astype(jnp.int32)
    large = jnp.minimum(large, REL_BUCKETS - 1)
    return jnp.where(dist < max_exact, dist, large)


def sliding_window_attention(q, k, v, sinks, rel_bias):
    B, S, Hq, Dh = q.shape
    Hkv = k.shape[2]
    G = Hq // Hkv
    nb = S // Q_BLOCK
    scale = Dh ** -0.5
    pad = ((0, 0), (Q_BLOCK, 0), (0, 0), (0, 0))
    kp = jnp.pad(k, pad).reshape(B, nb + 1, Q_BLOCK, Hkv, Dh)
    vp = jnp.pad(v, pad).reshape(B, nb + 1, Q_BLOCK, Hkv, Dh)
    kband = jnp.concatenate([kp[:, :-1], kp[:, 1:]], axis=2).transpose(1, 0, 2, 3, 4)
    vband = jnp.concatenate([vp[:, :-1], vp[:, 1:]], axis=2).transpose(1, 0, 2, 3, 4)
    qb = q.reshape(B, nb, Q_BLOCK, Hkv, G, Dh).transpose(1, 0, 2, 3, 4, 5)
    kpos = (jnp.arange(nb) * Q_BLOCK - Q_BLOCK)[:, None] + jnp.arange(2 * Q_BLOCK)[None, :]

    dist = jnp.arange(Q_BLOCK)[:, None] + Q_BLOCK - jnp.arange(2 * Q_BLOCK)[None, :]
    in_window = (dist >= 0) & (dist < WINDOW)
    bias = rel_bias.astype(jnp.float32)[t5_bucket(jnp.maximum(dist, 0))]
    bias = bias.transpose(2, 0, 1).reshape(Hkv, G, Q_BLOCK, 2 * Q_BLOCK)
    sink_logit = sinks.astype(jnp.float32).reshape(Hkv, G, 1, 1)

    def block(args):
        q_blk, k_blk, v_blk, kp_blk = args
        s = jnp.einsum('bqhgd,bkhd->bhgqk', q_blk, k_blk,
                       preferred_element_type=jnp.float32) * scale + bias
        valid = in_window & (kp_blk >= 0)[None, :]
        s = jnp.where(valid, s, -jnp.inf)
        sink = jnp.broadcast_to(sink_logit, s.shape[:-1] + (1,))
        w = jax.nn.softmax(jnp.concatenate([s, sink], axis=-1), axis=-1)[..., :-1]
        return jnp.einsum('bhgqk,bkhd->bqhgd', w.astype(v_blk.dtype), v_blk)

    out = lax.map(block, (qb, kband, vband, kpos))
    return out.transpose(1, 0, 2, 3, 4, 5).reshape(B, S, Hq, Dh)


def squared_relu_mlp(u, w_up, w_down):
    a = jax.nn.relu(u @ w_up)
    return (a * a) @ w_down


def setup_inputs(seed: int = 0) -> dict:
    key = jax.random.key(seed)
    ks = jax.random.split(key, 20)
    f32 = jnp.float32
    n_sb, n_fox, n_swa = _n_layers_of(0), _n_layers_of(1), _n_layers_of(2)
    d_in = D_MODEL ** -0.5
    attn_w = (SB_HEADS * HEAD_DIM) ** -0.5

    def nrm(k, shape, s):
        return jax.random.normal(k, shape, f32) * s

    fox_cols = 3 * FOX_HEADS * HEAD_DIM + FOX_HEADS
    swa_cols = (SWA_Q_HEADS + 2 * SWA_KV_HEADS) * HEAD_DIM
    return {
        "x": jax.random.normal(ks[0], (BATCH, SEQ, D_MODEL), f32),
        "p": jax.random.normal(ks[1], (DEPTH, BATCH, SEQ, PLE_DIM), f32),
        "attn_norm": 1.0 + nrm(ks[2], (DEPTH, D_MODEL), 0.02),
        "mlp_norm": 1.0 + nrm(ks[3], (DEPTH, D_MODEL), 0.02),
        "ple_norm": 1.0 + nrm(ks[4], (DEPTH, D_MODEL), 0.02),
        "final_norm": 1.0 + nrm(ks[5], (D_MODEL,), 0.02),
        "w_in_sb": nrm(ks[6], (n_sb, D_MODEL, 3 * SB_HEADS * HEAD_DIM), d_in),
        "w_out_sb": nrm(ks[7], (n_sb, SB_HEADS * HEAD_DIM, D_MODEL), attn_w),
        "w_in_fox": nrm(ks[8], (n_fox, D_MODEL, fox_cols), d_in),
        "b_forget": jax.random.uniform(ks[9], (n_fox, FOX_HEADS), f32, 1.0, 6.0),
        "w_out_fox": nrm(ks[10], (n_fox, FOX_HEADS * HEAD_DIM, D_MODEL), attn_w),
        "w_in_swa": nrm(ks[11], (n_swa, D_MODEL, swa_cols), d_in),
        "sinks": nrm(ks[12], (n_swa, SWA_Q_HEADS), 0.5),
        "w_out_swa": nrm(ks[13], (n_swa, SWA_Q_HEADS * HEAD_DIM, D_MODEL), attn_w),
        "rel_bias": nrm(ks[14], (REL_BUCKETS, SWA_Q_HEADS), 0.5),
        "w_up": nrm(ks[15], (DEPTH, D_MODEL, D_FF), d_in),
        "w_down": nrm(ks[16], (DEPTH, D_FF, D_MODEL), D_FF ** -0.5),
        "w_ple": nrm(ks[17], (DEPTH, PLE_DIM, D_MODEL), PLE_DIM ** -0.5),
        "w_ple_gate": nrm(ks[18], (DEPTH, D_MODEL, D_MODEL), d_in),
    }


def reference(x, p, attn_norm, mlp_norm, ple_norm, final_norm, w_in_sb, w_out_sb,
              w_in_fox, b_forget, w_out_fox, w_in_swa, sinks, w_out_swa, rel_bias,
              w_up, w_down, w_ple, w_ple_gate):
    qkv_w = SB_HEADS * HEAD_DIM
    h = x
    for i in range(DEPTH):
        kind = i % N_MIXERS
        j = i // N_MIXERS
        u = rms_norm(h, attn_norm[i])
        if kind == 0:
            proj = u @ w_in_sb[j]
            q = _heads(proj[..., :qkv_w], SB_HEADS)
            k = _heads(proj[..., qkv_w:2 * qkv_w], SB_HEADS)
            v = _heads(proj[..., 2 * qkv_w:], SB_HEADS)
            o = stick_breaking_attention(q, k, v)
            o = o.reshape(o.shape[0], o.shape[1], -1) @ w_out_sb[j]
        elif kind == 1:
            proj = u @ w_in_fox[j]
            fw = FOX_HEADS * HEAD_DIM
            q = _heads(proj[..., :fw], FOX_HEADS)
            k = _heads(proj[..., fw:2 * fw], FOX_HEADS)
            v = _heads(proj[..., 2 * fw:3 * fw], FOX_HEADS)
            f_logit = proj[..., 3 * fw:].astype(jnp.float32) + b_forget[j].astype(jnp.float32)
            o = forgetting_attention(q, k, v, jax.nn.log_sigmoid(f_logit))
            o = o.reshape(o.shape[0], o.shape[1], -1) @ w_out_fox[j]
        else:
            proj = u @ w_in_swa[j]
            qw = SWA_Q_HEADS * HEAD_DIM
            kw = SWA_KV_HEADS * HEAD_DIM
            q = _heads(proj[..., :qw], SWA_Q_HEADS)
            k = _heads(proj[..., qw:qw + kw], SWA_KV_HEADS)
            v = _heads(proj[..., qw + kw:], SWA_KV_HEADS)
            o = sliding_window_attention(q, k, v, sinks[j], rel_bias)
            o = o.reshape(o.shape[0], o.shape[1], -1) @ w_out_swa[j]
        h = h + o
        h = h + squared_relu_mlp(rms_norm(h, mlp_norm[i]), w_up[i], w_down[i])
        gate = jax.nn.sigmoid(rms_norm(h, ple_norm[i]) @ w_ple_gate[i])
        h = h + (p[i] @ w_ple[i]) * gate
    return rms_norm(h, final_norm)
```

```cpp
#include <hip/hip_runtime.h>
#include <hip/hip_cooperative_groups.h>
#include <hip/hip_bf16.h>
#include <cstdio>
#include <cstdint>
#include <cmath>
namespace cg = cooperative_groups;
__device__ __forceinline__ int tid_opaque() { int t = (int)threadIdx.x; asm volatile("" : "+v"(t)); return t; }
namespace pg8 {
#define PG8_LAS __attribute__((address_space(3)))
typedef unsigned short bf16_t;
typedef short bf16x8 __attribute__((ext_vector_type(8)));
typedef float f32x4 __attribute__((ext_vector_type(4)));
typedef unsigned u32x4 __attribute__((ext_vector_type(4)));
constexpr int BM = 256, BK = 64, HALF = 128, HTB = HALF * BK * 2  , STAGE_BYTES = 8 * HTB, NXCD = 8, WGM = 8;

__host__ __device__ __forceinline__ int lds_byte(int r, int c) { const int st = (r >> 4) * 2 + (c >> 5), rr = r & 15, cc = c & 31, ob = rr * 64 + cc * 2; return st * 1024 + (ob ^ (((ob >> 9) & 1) << 5)); }
__host__ __device__ __forceinline__ void stage_rc(int b, int& R, int& C) { const int st = b / 1024, sb = b % 1024, swz = sb ^ (((sb >> 9) & 1) << 5); R = (st >> 1) * 16 + swz / 64; C = (st & 1) * 32 + (swz % 64) / 2; }
__host__ __device__ __forceinline__ int perm32(int rho) { const int n = rho >> 4, i = rho & 15; return 8 * (i >> 2) + 4 * n + (i & 3); }

struct Unit { int pm, pn, idx; };
struct Gemm { const bf16_t* A; const bf16_t* Bt; int M, N, K; };

struct StaticOrder {
    int nM, nN, nwg, G, c;
    __host__ __device__ void init(int M, int N, int G_, int c_) { nM = M / BM; nN = N / BM; nwg = nM * nN; G = G_; c = c_; }
    __host__ __device__ bool next(int i, Unit& u) const {
        const long L = (long)i * G + c; if (L >= nwg) return false;
        int wgid = (int)L; { const int q = nwg / NXCD, r = nwg % NXCD, xcd = wgid % NXCD, off = wgid / NXCD; wgid = (xcd < r ? xcd * (q + 1) : r * (q + 1) + (xcd - r) * q) + off; }
        const int nig = WGM * nN, gid = wgid / nig, fm = gid * WGM, gsz = (nM - fm) < WGM ? (nM - fm) : WGM;
        u.pm = fm + ((wgid % nig) % gsz); u.pn = (wgid % nig) / gsz; u.idx = i; return true;
    }
    __device__ __forceinline__ void a_ready(const Unit&) const {}
    __device__ __forceinline__ void done(const Unit&) const {}
};
__device__ __forceinline__ unsigned cvt_pk_bf16(float lo, float hi) { unsigned r; asm volatile("v_cvt_pk_bf16_f32 %0, %1, %2" : "=v"(r) : "v"(lo), "v"(hi)); return r; }
typedef float f32x2 __attribute__((ext_vector_type(2)));
template <class Epi, class Sched, bool ALIGN_EPI = false, bool SP2 = false>
__device__ __forceinline__ void gemm_phase(PG8_LAS unsigned char* lds, const Gemm g, const Sched& S, const Epi& E) {
    const int tid = tid_opaque(), wid = __builtin_amdgcn_readfirstlane(tid >> 6), lane = tid & 63, wr = wid >> 2, wc = wid & 3, fr = lane & 15, fq = lane >> 4;
    const int K = g.K, nt = K / BK;
    unsigned voffA[2], voffB[2];
#pragma unroll
    for (int i = 0; i < 2; ++i) { int R, C; stage_rc(tid * 16 + i * 8192, R, C); const int Rb = Epi::PERM ? ((R & ~31) + perm32(R & 31)) : R;
        voffA[i] = (unsigned)(R * K + C) * 2u; voffB[i] = (unsigned)(Rb * K + C) * 2u; }
    const size_t kstep = (size_t)(BK * 2);
    const size_t hstep = (size_t)HALF * K * 2;
    const size_t tstep = 2 * hstep;
    const unsigned ldsw = (unsigned)wid * 1024u;
    const int aoff = lds_byte(wr * 64 + fr, fq * 8), boff = lds_byte(wc * 32 + fr, fq * 8);
#define PG8_SA(b, h) (((b) * 2 + (h)) * HTB)
#define PG8_SB(b, h) ((4 + (b) * 2 + (h)) * HTB)
#define PG8_STAGE(bufoff, gbase, voff) do { _Pragma("unroll") for (int _i = 0; _i < 2; ++_i) \
        __builtin_amdgcn_global_load_lds((const unsigned*)((const char*)(gbase) + (voff)[_i]), (PG8_LAS unsigned*)(lds + (bufoff) + ldsw + _i * 8192), 16, 0, 0); } while (0)
#define PG8_LDA(dst, b, h) do { _Pragma("unroll") for (int m = 0; m < 4; ++m) _Pragma("unroll") for (int k = 0; k < 2; ++k) dst[m][k] = *(const PG8_LAS bf16x8*)(lds + PG8_SA(b, h) + aoff + m * 2048 + k * 1024); } while (0)
#define PG8_LDB(dst, b, h) do { _Pragma("unroll") for (int n = 0; n < 2; ++n) _Pragma("unroll") for (int k = 0; k < 2; ++k) dst[n][k] = *(const PG8_LAS bf16x8*)(lds + PG8_SB(b, h) + boff + n * 2048 + k * 1024); } while (0)
#define PG8_MMA(ai, bj, At, Bt) do { __builtin_amdgcn_s_setprio(1); _Pragma("unroll") for (int m = 0; m < 4; ++m) _Pragma("unroll") for (int n = 0; n < 2; ++n) _Pragma("unroll") for (int k = 0; k < 2; ++k) \
        acc[ai][bj][m][n] = __builtin_amdgcn_mfma_f32_16x16x32_bf16(Bt[n][k], At[m][k], acc[ai][bj][m][n], 0, 0, 0); __builtin_amdgcn_s_setprio(0); } while (0)
#define PG8_WAIT_V(n) asm volatile("s_waitcnt vmcnt(" #n ")" ::: "memory")
#define PG8_WAIT_L(n) asm volatile("s_waitcnt lgkmcnt(" #n ")" ::: "memory")
#define PG8_BAR __builtin_amdgcn_s_barrier()
#define PG8_SCHED __builtin_amdgcn_sched_barrier(0)
    Unit cur, nxt; int ui = 0;
    if (!S.next(0, cur)) return;
    f32x4 acc[2][2][4][2];
#pragma unroll
    for (int a = 0; a < 2; ++a)
#pragma unroll
        for (int b = 0; b < 2; ++b)
#pragma unroll
            for (int m = 0; m < 4; ++m)
#pragma unroll
                for (int n = 0; n < 2; ++n) acc[a][b][m][n] = (f32x4){0.f, 0.f, 0.f, 0.f};
    bf16x8 At[4][2], B0[2][2], B1[2][2];
    const char* cA = (const char*)g.A + (size_t)cur.pm * tstep; const char* cB = (const char*)g.Bt + (size_t)cur.pn * tstep;
    S.a_ready(cur);
    if constexpr (SP2) {
        PG8_STAGE(PG8_SB(0, 0), cB, voffB); PG8_STAGE(PG8_SB(0, 1), cB + hstep, voffB); PG8_STAGE(PG8_SA(0, 0), cA, voffA); PG8_STAGE(PG8_SA(0, 1), cA + hstep, voffA);
        if (wr == 1) PG8_BAR;
        PG8_WAIT_V(2); PG8_BAR;
        PG8_STAGE(PG8_SB(1, 0), cB + kstep, voffB); PG8_STAGE(PG8_SA(1, 0), cA + kstep, voffA); PG8_STAGE(PG8_SB(1, 1), cB + hstep + kstep, voffB);
        PG8_WAIT_V(6); PG8_BAR;
    } else {
        PG8_STAGE(PG8_SB(0, 0), cB, voffB); PG8_STAGE(PG8_SA(0, 0), cA, voffA); PG8_STAGE(PG8_SB(0, 1), cB + hstep, voffB); PG8_STAGE(PG8_SA(0, 1), cA + hstep, voffA);
        if (wr == 1) PG8_BAR;
        PG8_WAIT_V(4); PG8_BAR;
        PG8_STAGE(PG8_SB(1, 0), cB + kstep, voffB); PG8_STAGE(PG8_SA(1, 0), cA + kstep, voffA); PG8_STAGE(PG8_SB(1, 1), cB + hstep + kstep, voffB);
        PG8_WAIT_V(6); PG8_BAR;
    }
    for (;;) {
        const bool has_next = S.next(ui + 1, nxt);
        const char* nA = has_next ? (const char*)g.A + (size_t)nxt.pm * tstep : cA; const char* nB = has_next ? (const char*)g.Bt + (size_t)nxt.pn * tstep : cB;
        for (int t = 0; t < nt; t += 2) {
            const bool last = (t == nt - 2);
            const char* a1 = cA + (size_t)(t + 1) * kstep;
            const char* a2 = last ? nA : cA + (size_t)(t + 2) * kstep; const char* b2 = last ? nB : cB + (size_t)(t + 2) * kstep;
            const char* a3 = a2 + kstep; const char* b3 = b2 + kstep;
            if (last && has_next) S.a_ready(nxt);
            if constexpr (SP2) {
            PG8_LDB(B0, 0, 0); PG8_LDB(B1, 0, 1); PG8_SCHED; PG8_LDA(At, 0, 0); PG8_STAGE(PG8_SA(1, 1), a1 + hstep, voffA);
            PG8_WAIT_V(8); PG8_WAIT_L(0); PG8_BAR; PG8_MMA(0, 0, At, B0); PG8_MMA(0, 1, At, B1); PG8_BAR; PG8_SCHED;
            PG8_LDA(At, 0, 1); PG8_STAGE(PG8_SB(0, 0), b2, voffB); PG8_STAGE(PG8_SB(0, 1), b2 + hstep, voffB); PG8_STAGE(PG8_SA(0, 0), a2, voffA);
            PG8_WAIT_V(8); PG8_WAIT_L(0); PG8_BAR; PG8_MMA(1, 0, At, B0); PG8_MMA(1, 1, At, B1); PG8_BAR; PG8_SCHED;
            PG8_LDB(B0, 1, 0); PG8_LDB(B1, 1, 1); PG8_SCHED; PG8_LDA(At, 1, 0); PG8_STAGE(PG8_SA(0, 1), a2 + hstep, voffA);
            PG8_WAIT_V(8); PG8_WAIT_L(0); PG8_BAR; PG8_MMA(0, 0, At, B0); PG8_MMA(0, 1, At, B1); PG8_BAR; PG8_SCHED;
            PG8_LDA(At, 1, 1); PG8_STAGE(PG8_SB(1, 0), b3, voffB); PG8_STAGE(PG8_SB(1, 1), b3 + hstep, voffB); PG8_STAGE(PG8_SA(1, 0), a3, voffA);
            PG8_WAIT_V(8); PG8_WAIT_L(0); PG8_BAR; PG8_MMA(1, 0, At, B0); PG8_MMA(1, 1, At, B1); PG8_BAR; PG8_SCHED;
            } else {
            PG8_LDB(B0, 0, 0); PG8_SCHED; PG8_LDA(At, 0, 0); PG8_STAGE(PG8_SA(1, 1), a1 + hstep, voffA);
            PG8_WAIT_L(8); PG8_BAR; PG8_WAIT_L(0); PG8_MMA(0, 0, At, B0); PG8_BAR; PG8_SCHED;
            PG8_LDB(B1, 0, 1); PG8_STAGE(PG8_SB(0, 0), b2, voffB);
            PG8_BAR; PG8_WAIT_L(0); PG8_MMA(0, 1, At, B1); PG8_BAR;
            PG8_LDA(At, 0, 1); PG8_STAGE(PG8_SA(0, 0), a2, voffA);
            PG8_BAR; PG8_WAIT_L(0); PG8_MMA(1, 0, At, B0); PG8_BAR; PG8_SCHED;
            PG8_STAGE(PG8_SB(0, 1), b2 + hstep, voffB);
            PG8_WAIT_V(6); PG8_BAR; PG8_MMA(1, 1, At, B1); PG8_BAR;
            PG8_LDB(B0, 1, 0); PG8_SCHED; PG8_LDA(At, 1, 0); PG8_STAGE(PG8_SA(0, 1), a2 + hstep, voffA);
            PG8_WAIT_L(8); PG8_BAR; PG8_WAIT_L(0); PG8_MMA(0, 0, At, B0); PG8_BAR; PG8_SCHED;
            PG8_LDB(B1, 1, 1); PG8_STAGE(PG8_SB(1, 0), b3, voffB);
            PG8_BAR; PG8_WAIT_L(0); PG8_MMA(0, 1, At, B1); PG8_BAR;
            PG8_LDA(At, 1, 1); PG8_STAGE(PG8_SA(1, 0), a3, voffA);
            PG8_BAR; PG8_WAIT_L(0); PG8_MMA(1, 0, At, B0); PG8_BAR; PG8_SCHED;
            PG8_STAGE(PG8_SB(1, 1), b3 + hstep, voffB);
            PG8_WAIT_V(6); PG8_BAR; PG8_MMA(1, 1, At, B1); PG8_BAR;
            }
        }
        if constexpr (ALIGN_EPI) { if (wr == 0) PG8_BAR; }
        if constexpr (!Epi::AFTER_DRAIN) { E(acc, cur, wr, wc, fr, fq); S.done(cur); }
        if (!has_next) break;
#pragma unroll
        for (int a = 0; a < 2; ++a)
#pragma unroll
            for (int b = 0; b < 2; ++b)
#pragma unroll
                for (int m = 0; m < 4; ++m)
#pragma unroll
                    for (int n = 0; n < 2; ++n) acc[a][b][m][n] = (f32x4){0.f, 0.f, 0.f, 0.f};
        cur = nxt; cA = nA; cB = nB; ++ui;
        if constexpr (ALIGN_EPI) { if (wr == 1) PG8_BAR; }
    }
    PG8_WAIT_V(0);
    if constexpr (!ALIGN_EPI) { if (wr == 0) PG8_BAR; }
    PG8_BAR;
    if constexpr (Epi::AFTER_DRAIN) { E.fused(acc, cur, wr, wc, fr, fq, lds, wid, lane); S.done(cur); }
#undef PG8_SA
#undef PG8_SB
#undef PG8_STAGE
#undef PG8_LDA
#undef PG8_LDB
#undef PG8_MMA
#undef PG8_WAIT_V
#undef PG8_WAIT_L
#undef PG8_BAR
#undef PG8_SCHED
}
}

namespace epi {
using pg8::f32x4; using pg8::u32x4; using pg8::bf16_t; using pg8::Unit; using pg8::cvt_pk_bf16; using pg8::BM; using pg8::HALF;
typedef unsigned u32x2 __attribute__((ext_vector_type(2)));
constexpr float EPS = 1e-6f, LOG2E = 1.4426950408889634f;
__device__ __forceinline__ float rstd_of(const float* ssq, int row) { const f32x4* p = (const f32x4*)(ssq + (size_t)row * 16); const f32x4 a = p[0], b = p[1], c = p[2], d = p[3];
    const float s = (((a[0] + a[1]) + (a[2] + a[3])) + ((b[0] + b[1]) + (b[2] + b[3]))) + (((c[0] + c[1]) + (c[2] + c[3])) + ((d[0] + d[1]) + (d[2] + d[3]))); return rsqrtf(s * (1.0f / 1024.0f) + EPS); }

constexpr int RSTD_LDS_OFF = 131072 + 1024;
__device__ __forceinline__ float rstd_lds(const Unit& u, int row) { return ((const __attribute__((address_space(3))) float*)(RSTD_LDS_OFF))[u.idx * 256 + (row & 255)]; }
template <class Sched> __device__ __forceinline__ void fill_rstd(const float* ssq, const Sched& S) {
    const int tid = tid_opaque(); Unit u;
    if (tid < 256) { for (int i = 0; S.next(i, u); ++i) ((__attribute__((address_space(3))) float*)(RSTD_LDS_OFF))[i * 256 + tid] = rstd_of(ssq, u.pm * BM + tid); }
    __syncthreads();
}
struct EpiQkv {
    static constexpr bool PERM = true, AFTER_DRAIN = false;
    const float* ssq; bf16_t *q, *k, *v; int nk, kvp; float qscale; float* lf; const float* bfor;
    __device__ __forceinline__ void operator()(const f32x4 (&acc)[2][2][4][2], const Unit& u, int wr, int wc, int fr, int fq) const {
        const int row0 = u.pm * BM + wr * 64 + fr; const int pn = u.pn;
        if (pn >= 4 + 2 * nk) {
            if (wc == 0 && fq < 2) {
#pragma unroll
                for (int ai = 0; ai < 2; ++ai)
#pragma unroll
                    for (int m = 0; m < 4; ++m) { const int row = row0 + ai * HALF + m * 16; const float rs = rstd_lds(u, row);
#pragma unroll
                        for (int n = 0; n < 2; ++n) { const int c = 8 * fq + 4 * n; const f32x4 a = acc[ai][0][m][n]; f32x4 o;
#pragma unroll
                            for (int i = 0; i < 4; ++i) { const float x = a[i] * rs + bfor[c + i]; o[i] = fminf(x, 0.f) - 0.6931471805599453f * __builtin_amdgcn_logf(1.0f + __builtin_amdgcn_exp2f(-LOG2E * fabsf(x))); }
                            *(f32x4*)(lf + (size_t)row * 16 + c) = o; } }
            }
            return;
        }
        bf16_t* base; int pitch, colt; float sc = 1.f;
        if (pn < 4) { base = q; pitch = 1024; colt = pn * 256; sc = qscale; }
        else if (pn < 4 + nk) { base = k; pitch = kvp; colt = (pn - 4) * 256; }
        else { base = v; pitch = kvp; colt = (pn - 4 - nk) * 256; }
        const int col0 = colt + wc * 32 + 8 * fq;
#pragma unroll
        for (int ai = 0; ai < 2; ++ai)
#pragma unroll
            for (int m = 0; m < 4; ++m) { const int row = row0 + ai * HALF + m * 16; const float rs = rstd_lds(u, row) * sc; bf16_t* rowp = base + (size_t)row * pitch + col0;
#pragma unroll
                for (int bj = 0; bj < 2; ++bj) { const f32x4 v0 = acc[ai][bj][m][0] * rs, v1 = acc[ai][bj][m][1] * rs; u32x4 w;
                    w.x = cvt_pk_bf16(v0[0], v0[1]); w.y = cvt_pk_bf16(v0[2], v0[3]); w.z = cvt_pk_bf16(v1[0], v1[1]); w.w = cvt_pk_bf16(v1[2], v1[3]);
                    *(u32x4*)(rowp + bj * HALF) = w; }
                asm volatile("" ::: "memory"); }
    }
};
template <int ACT> struct EpiAct {
    static constexpr bool PERM = true, AFTER_DRAIN = false;
    const float* ssq; bf16_t* O; int ldc;
    __device__ __forceinline__ void operator()(const f32x4 (&acc)[2][2][4][2], const Unit& u, int wr, int wc, int fr, int fq) const {
        const int row0 = u.pm * BM + wr * 64 + fr; const int col0 = u.pn * BM + wc * 32 + 8 * fq;
#pragma unroll
        for (int ai = 0; ai < 2; ++ai)
#pragma unroll
            for (int m = 0; m < 4; ++m) { const int row = row0 + ai * HALF + m * 16; const float rs = rstd_lds(u, row); bf16_t* rowp = O + (size_t)row * ldc + col0;
#pragma unroll
                for (int bj = 0; bj < 2; ++bj) { f32x4 v0 = acc[ai][bj][m][0] * rs, v1 = acc[ai][bj][m][1] * rs;
                    if (ACT == 1) {
#pragma unroll
                        for (int i = 0; i < 4; ++i) { const float a = __builtin_amdgcn_fmed3f(v0[i], 0.f, 3.0e38f), b = __builtin_amdgcn_fmed3f(v1[i], 0.f, 3.0e38f); v0[i] = a * a; v1[i] = b * b; } }
                    u32x4 w; w.x = cvt_pk_bf16(v0[0], v0[1]); w.y = cvt_pk_bf16(v0[2], v0[3]); w.z = cvt_pk_bf16(v1[0], v1[1]); w.w = cvt_pk_bf16(v1[2], v1[3]);
                    *(u32x4*)(rowp + bj * HALF) = w; }
                asm volatile("" ::: "memory"); }
    }
};
struct EpiDump {
    static constexpr bool PERM = true, AFTER_DRAIN = false;
    float* scr;
    __device__ __forceinline__ void operator()(const f32x4 (&acc)[2][2][4][2], const Unit& u, int wr, int wc, int fr, int fq) const {
        typedef __attribute__((address_space(1))) u32x4 gu32x4;
        gu32x4* p = (gu32x4*)((u32x4*)scr + (size_t)(u.pm * 4 + u.pn) * 16 * 512 + tid_opaque() * 2);
#pragma unroll
        for (int ai = 0; ai < 2; ++ai)
#pragma unroll
            for (int m = 0; m < 4; ++m) {
#pragma unroll
                for (int bj = 0; bj < 2; ++bj) { const f32x4 v0 = acc[ai][bj][m][0], v1 = acc[ai][bj][m][1]; u32x4 w;
                    w.x = cvt_pk_bf16(v0[0], v0[1]); w.y = cvt_pk_bf16(v0[2], v0[3]); w.z = cvt_pk_bf16(v1[0], v1[1]); w.w = cvt_pk_bf16(v1[2], v1[3]); p[bj] = w; }
                p += 1024; asm volatile("" : "+v"(p) :: "memory"); }
    }
};
template <int GATE> struct EpiRes {
    static constexpr bool PERM = true, AFTER_DRAIN = false;
    const bf16_t* hin; bf16_t* hb; float* ssq_out; const float* ssq_in; const float* scr;
    __device__ __forceinline__ void operator()(const f32x4 (&acc)[2][2][4][2], const Unit& u, int wr, int wc, int fr, int fq) const {
        const int row0 = u.pm * BM + wr * 64 + fr; const int col0 = u.pn * BM + wc * 32 + 8 * fq;
        typedef __attribute__((address_space(1))) const u32x4 gcu32x4;
        gcu32x4* sp = (gcu32x4*)((const u32x4*)scr + (size_t)(u.pm * 4 + u.pn) * 16 * 512 + tid_opaque() * 2);
#pragma unroll
        for (int ai = 0; ai < 2; ++ai)
#pragma unroll
            for (int m = 0; m < 4; ++m) { const int row = row0 + ai * HALF + m * 16; const size_t off = (size_t)row * 1024 + col0; float part = 0.f;
                float rs = 0.f; if (GATE) rs = rstd_lds(u, row) * (-LOG2E);
#pragma unroll
                for (int bj = 0; bj < 2; ++bj) { const u32x4 hw = *(const u32x4*)(hin + off + bj * HALF); u32x4 pw; if (GATE) pw = sp[bj]; u32x4 wout;
#pragma unroll
                    for (int n = 0; n < 2; ++n) { const unsigned h0 = n ? hw.z : hw.x, h1 = n ? hw.w : hw.y;
                        f32x4 hv = {__uint_as_float(h0 << 16), __uint_as_float(h0 & 0xffff0000u), __uint_as_float(h1 << 16), __uint_as_float(h1 & 0xffff0000u)}; f32x4 a = acc[ai][bj][m][n];
                        if (GATE) { const unsigned w0 = n ? pw.z : pw.x, w1 = n ? pw.w : pw.y; const f32x4 pe = {__uint_as_float(w0 << 16), __uint_as_float(w0 & 0xffff0000u), __uint_as_float(w1 << 16), __uint_as_float(w1 & 0xffff0000u)};
#pragma unroll
                            for (int i = 0; i < 4; ++i) a[i] = pe[i] * __builtin_amdgcn_rcpf(1.0f + __builtin_amdgcn_exp2f(a[i] * rs)); }
                        hv += a;
                        const unsigned o0_ = cvt_pk_bf16(hv[0], hv[1]), o1_ = cvt_pk_bf16(hv[2], hv[3]);
                        if (n) { wout.z = o0_; wout.w = o1_; } else { wout.x = o0_; wout.y = o1_; }
                        part += (hv[0] * hv[0] + hv[1] * hv[1]) + (hv[2] * hv[2] + hv[3] * hv[3]); }
                    *(u32x4*)(hb + off + bj * HALF) = wout; }
                { auto r1 = __builtin_amdgcn_permlane16_swap(__float_as_uint(part), __float_as_uint(part), false, false); part = __uint_as_float(r1[0]) + __uint_as_float(r1[1]);
                  auto r2 = __builtin_amdgcn_permlane32_swap(__float_as_uint(part), __float_as_uint(part), false, false); part = __uint_as_float(r2[0]) + __uint_as_float(r2[1]); }
                if (fq == 0) ssq_out[(size_t)row * 16 + u.pn * 4 + wc] = part;
                if (GATE) { sp += 1024; asm volatile("" : "+v"(sp)); }
                if (GATE ? (m & 1) : (m == 3)) asm volatile("" ::: "memory"); }
    }
};
}

namespace att {
typedef unsigned short bf16_t;
typedef short bf16x8 __attribute__((ext_vector_type(8)));
typedef float f32x16 __attribute__((ext_vector_type(16)));
typedef float f32x4 __attribute__((ext_vector_type(4)));
typedef unsigned u32x4 __attribute__((ext_vector_type(4)));
typedef short v4i16 __attribute__((ext_vector_type(4)));
#define ALDS __attribute__((address_space(3)))
constexpr int S = 4096, KSTR = 144, VSTR = 192, KBUF = 64 * KSTR, VBUF = 64 * VSTR;
constexpr int OFF_K = 0, OFF_V = 2 * KBUF, OFF_CK = OFF_V + 2 * VBUF, OFF_FLAG = OFF_CK + 512, OFF_WSF = OFF_FLAG + 64, OFF_BIAS = OFF_WSF + 8 * 64 * 4, LDS_END = OFF_BIAS + 512;
constexpr float LOG2E = 1.4426950408889634f;
enum { SB = 0, FOX = 1, SWA = 2 };
constexpr float RESCALE_THR = 8.0f;
constexpr float DEAD_LOG2 = 128.0f;
__device__ __forceinline__ int crow(int r, int hi) { return (r & 3) + 8 * (r >> 2) + 4 * hi; }
typedef float f32x2_t __attribute__((ext_vector_type(2))); typedef __bf16 bf16x2_t __attribute__((ext_vector_type(2)));
__device__ __forceinline__ unsigned pk(float lo, float hi) { f32x2_t v = {lo, hi}; bf16x2_t b = __builtin_convertvector(v, bf16x2_t); return __builtin_bit_cast(unsigned, b); }
__device__ __forceinline__ v4i16 vtr(const ALDS unsigned char* p) { return __builtin_amdgcn_ds_read_tr16_b64_v4i16((ALDS v4i16*)p); }
__device__ __forceinline__ bf16x8 pack8(const f32x16& p, int b) {
    u32x4 w; w.x = pk(p[b], p[b + 1]); w.y = pk(p[b + 2], p[b + 3]); w.z = pk(p[b + 4], p[b + 5]); w.w = pk(p[b + 6], p[b + 7]); return __builtin_bit_cast(bf16x8, w); }

struct AttnArgs { const bf16_t* Q; const bf16_t* K; const bf16_t* V; bf16_t* O; int kvp; const float* cl; const float* relb; const float* sinks; const unsigned* kmax2; unsigned* qctr; };

template <int MODE, bool MASK>
__device__ __forceinline__ void tile_qk(const ALDS unsigned char* kbuf, const ALDS float* ckb, const ALDS float* biastab, ALDS float* wsf,
                                        const bf16x8 (&qr)[4], f32x16& o0, f32x16& o1, float& m, float& l, float& carry, const float cq, const int kt, const int qrow,
                                        const int r32, const int hi, const int lane, const bf16x8 (&tf)[2], bf16x8 (&pa)[4]) {
    f32x16 p0, p1;
    const ALDS unsigned char* kb = kbuf + r32 * KSTR + hi * 16;
    const int kbase = kt * 64 + 4 * hi - qrow;
    if (MODE == SB) {
#pragma unroll
        for (int half = 1; half >= 0; --half) {
            const bf16x8 zero8 = (bf16x8){0, 0, 0, 0, 0, 0, 0, 0};
            if (MASK && half == 1 && (kt * 64 + 32 > __builtin_amdgcn_readfirstlane(qrow) + 31)) { pa[2] = zero8; pa[3] = zero8; continue; }
            if (half == 0 && __all(carry > DEAD_LOG2)) { pa[0] = zero8; pa[1] = zero8; break; }
            f32x16 p; bf16x8 kf4[4];
#pragma unroll
            for (int r = 0; r < 16; ++r) p[r] = 0.f;
#pragma unroll
            for (int dc = 0; dc < 4; ++dc) kf4[dc] = *(const ALDS bf16x8*)(kb + half * 32 * KSTR + dc * 32);
            __builtin_amdgcn_sched_barrier(0);
#pragma unroll
            for (int dc = 0; dc < 4; ++dc) p = __builtin_amdgcn_mfma_f32_32x32x16_bf16(kf4[dc], qr[dc], p, 0, 0, 0);
            f32x16 x;
#pragma unroll
            for (int r = 0; r < 16; ++r) { const int ko = (r & 3) + 8 * (r >> 2) + 32 * half;
                const float z = fminf(p[r], 126.f); float L = __builtin_amdgcn_logf(1.0f + __builtin_amdgcn_exp2f(z)); if (MASK) L = (kbase + ko < 0) ? L : 0.f; x[r] = L; p[r] = z - L; }
            u32x4 hh[2];
#pragma unroll
            for (int s = 0; s < 2; ++s)
#pragma unroll
                for (int i = 0; i < 4; ++i) hh[s][i] = pk(x[8 * s + 2 * i], x[8 * s + 2 * i + 1]);
            f32x16 y;
#pragma unroll
            for (int r = 0; r < 16; ++r) y[r] = carry;
            y = __builtin_amdgcn_mfma_f32_32x32x16_bf16(tf[0], __builtin_bit_cast(bf16x8, hh[0]), y, 0, 0, 0);
            y = __builtin_amdgcn_mfma_f32_32x32x16_bf16(tf[1], __builtin_bit_cast(bf16x8, hh[1]), y, 0, 0, 0);
            const float nc = y[0] + __uint_as_float(hh[0][0] << 16);
            carry = __shfl(nc, r32);
#pragma unroll
            for (int r = 0; r < 16; ++r) { const int ko = (r & 3) + 8 * (r >> 2) + 32 * half;
                float w = __builtin_amdgcn_exp2f(p[r] - y[r]); if (MASK) w = (kbase + ko < 0) ? w : 0.f; p[r] = w; }
            pa[2 * half] = pack8(p, 0); pa[2 * half + 1] = pack8(p, 8);
            __builtin_amdgcn_sched_barrier(0);
        }
    } else {
        const float NEG = -INFINITY;
        if (MODE == FOX) {
            const float cref = ckb[63];
            const float cin = MASK ? (cq - cref) : (cq - cref - m);
#pragma unroll
            for (int r = 0; r < 16; ++r) { p0[r] = cin; p1[r] = cin; }
            { const ALDS unsigned char* ka = kbuf + r32 * KSTR + 128;
              bf16x8 qa; qa[0] = hi ? (short)0 : (short)0x3F80; qa[1] = qa[0]; qa[2] = 0; qa[3] = 0; qa[4] = 0; qa[5] = 0; qa[6] = 0; qa[7] = 0;
              bf16x8 f0[5], f1[5];
#pragma unroll
              for (int dc = 0; dc < 4; ++dc) { f0[dc] = *(const ALDS bf16x8*)(kb + dc * 32); f1[dc] = *(const ALDS bf16x8*)(kb + 32 * KSTR + dc * 32); }
              f0[4] = *(const ALDS bf16x8*)ka; f1[4] = *(const ALDS bf16x8*)(ka + 32 * KSTR);
              __builtin_amdgcn_sched_barrier(0);
#pragma unroll
              for (int dc = 0; dc < 4; ++dc) { p0 = __builtin_amdgcn_mfma_f32_32x32x16_bf16(f0[dc], qr[dc], p0, 0, 0, 0); p1 = __builtin_amdgcn_mfma_f32_32x32x16_bf16(f1[dc], qr[dc], p1, 0, 0, 0); }
              p0 = __builtin_amdgcn_mfma_f32_32x32x16_bf16(f0[4], qa, p0, 0, 0, 0); p1 = __builtin_amdgcn_mfma_f32_32x32x16_bf16(f1[4], qa, p1, 0, 0, 0); }
            if (MASK) {
#pragma unroll
                for (int r = 0; r < 16; ++r) { const int ko = (r & 3) + 8 * (r >> 2); if (kbase + ko > 0) p0[r] = NEG; if (kbase + ko + 32 > 0) p1[r] = NEG; }
            }
            float mq[4];
#pragma unroll
            for (int r = 0; r < 4; ++r) mq[r] = fmaxf(p0[r], p1[r]);
#pragma unroll
            for (int r = 4; r < 16; ++r) mq[r & 3] = fmaxf(mq[r & 3], fmaxf(p0[r], p1[r]));
            float mx = fmaxf(fmaxf(mq[0], mq[1]), fmaxf(mq[2], mq[3]));
            { auto rr = __builtin_amdgcn_permlane32_swap(__float_as_uint(mx), __float_as_uint(mx), false, false); mx = fmaxf(__uint_as_float(rr[0]), __uint_as_float(rr[1])); }
            if (MASK) {
                m = mx;
#pragma unroll
                for (int r = 0; r < 16; ++r) { p0[r] -= mx; p1[r] -= mx; }
            } else if (__any(mx > RESCALE_THR)) {
                const float d = fmaxf(mx, 0.f); m += d; const float f = __builtin_amdgcn_exp2f(-d); l *= f;
                if (hi == 0) wsf[r32] = f;
#pragma unroll
                for (int r = 0; r < 16; ++r) { const float fr = wsf[crow(r, hi)]; o0[r] *= fr; o1[r] *= fr; p0[r] -= d; p1[r] -= d; }
            }
            float lq[4] = {0.f, 0.f, 0.f, 0.f};
#pragma unroll
            for (int r = 0; r < 16; ++r) { p0[r] = __builtin_amdgcn_exp2f(p0[r]); p1[r] = __builtin_amdgcn_exp2f(p1[r]); lq[r & 3] += p0[r] + p1[r]; }
            l += (lq[0] + lq[1]) + (lq[2] + lq[3]);
        } else {
#pragma unroll
            for (int r = 0; r < 16; ++r) { p0[r] = 0.f; p1[r] = 0.f; }
            { bf16x8 f0[4], f1[4];
#pragma unroll
              for (int dc = 0; dc < 4; ++dc) { f0[dc] = *(const ALDS bf16x8*)(kb + dc * 32); f1[dc] = *(const ALDS bf16x8*)(kb + 32 * KSTR + dc * 32); }
              __builtin_amdgcn_sched_barrier(0);
#pragma unroll
              for (int dc = 0; dc < 4; ++dc) { p0 = __builtin_amdgcn_mfma_f32_32x32x16_bf16(f0[dc], qr[dc], p0, 0, 0, 0); p1 = __builtin_amdgcn_mfma_f32_32x32x16_bf16(f1[dc], qr[dc], p1, 0, 0, 0); } }
#pragma unroll
            for (int r = 0; r < 16; ++r) { const int ko = (r & 3) + 8 * (r >> 2);
                { const int dist = -(kbase + ko); const bool ok = (unsigned)dist < 128u; const float bv = biastab[dist & 127]; p0[r] = ok ? p0[r] + bv : NEG; }
                { const int dist = -(kbase + ko + 32); const bool ok = (unsigned)dist < 128u; const float bv = biastab[dist & 127]; p1[r] = ok ? p1[r] + bv : NEG; } }
            float mq[4];
#pragma unroll
            for (int r = 0; r < 4; ++r) mq[r] = fmaxf(p0[r], p1[r]);
#pragma unroll
            for (int r = 4; r < 16; ++r) mq[r & 3] = fmaxf(mq[r & 3], fmaxf(p0[r], p1[r]));
            float mx = fmaxf(fmaxf(mq[0], mq[1]), fmaxf(mq[2], mq[3]));
            { auto rr = __builtin_amdgcn_permlane32_swap(__float_as_uint(mx), __float_as_uint(mx), false, false); mx = fmaxf(__uint_as_float(rr[0]), __uint_as_float(rr[1])); }
            if (__any(mx > m + RESCALE_THR)) {
                const float mnew = fmaxf(m, mx); const float f = __builtin_amdgcn_exp2f(m - mnew); l *= f; m = mnew;
                if (hi == 0) wsf[r32] = f;
#pragma unroll
                for (int r = 0; r < 16; ++r) { const float fr = wsf[crow(r, hi)]; o0[r] *= fr; o1[r] *= fr; }
            }
            float lq[4] = {0.f, 0.f, 0.f, 0.f};
#pragma unroll
            for (int r = 0; r < 16; ++r) { p0[r] = __builtin_amdgcn_exp2f(p0[r] - m); p1[r] = __builtin_amdgcn_exp2f(p1[r] - m); lq[r & 3] += p0[r] + p1[r]; }
            l += (lq[0] + lq[1]) + (lq[2] + lq[3]);
        }
    }
    if (MODE != SB) { pa[0] = pack8(p0, 0); pa[1] = pack8(p0, 8); pa[2] = pack8(p1, 0); pa[3] = pack8(p1, 8); }
}
__device__ __forceinline__ void tile_pv(const ALDS unsigned char* vbuf, const bf16x8 (&pa)[4], f32x16& o0, f32x16& o1, const int hi, const int lane) {
    const ALDS unsigned char* vb = vbuf + (4 * hi + ((lane & 15) >> 2)) * VSTR + ((lane >> 4) & 1) * 32 + (lane & 3) * 8;
    v4i16 va[4], vb_[4], vc[4], vd[4];
#pragma unroll
    for (int s = 0; s < 4; ++s) { va[s] = vtr(vb + s * 16 * VSTR); vb_[s] = vtr(vb + s * 16 * VSTR + 8 * VSTR); vc[s] = vtr(vb + s * 16 * VSTR + 64); vd[s] = vtr(vb + s * 16 * VSTR + 8 * VSTR + 64); }
    __builtin_amdgcn_sched_barrier(0);
#pragma unroll
    for (int s = 0; s < 4; ++s) {
        const bf16x8 v0 = (bf16x8){va[s][0], va[s][1], va[s][2], va[s][3], vb_[s][0], vb_[s][1], vb_[s][2], vb_[s][3]}, v1 = (bf16x8){vc[s][0], vc[s][1], vc[s][2], vc[s][3], vd[s][0], vd[s][1], vd[s][2], vd[s][3]};
        o0 = __builtin_amdgcn_mfma_f32_32x32x16_bf16(pa[s], v0, o0, 0, 0, 0);
        o1 = __builtin_amdgcn_mfma_f32_32x32x16_bf16(pa[s], v1, o1, 0, 0, 0);
    }
}


__device__ __forceinline__ void sb_tile_pipelined(const ALDS unsigned char* kbuf, const ALDS unsigned char* vbuf, const bf16x8 (&qr)[4], f32x16& o0, f32x16& o1, float& carry,
                                                  const int r32, const int hi, const int lane, const bf16x8 (&tf)[2]) {
    const ALDS unsigned char* kb = kbuf + r32 * KSTR + hi * 16;
    bf16x8 k1[4], k0[4];
#pragma unroll
    for (int dc = 0; dc < 4; ++dc) { k1[dc] = *(const ALDS bf16x8*)(kb + 32 * KSTR + dc * 32); k0[dc] = *(const ALDS bf16x8*)(kb + dc * 32); }
    __builtin_amdgcn_sched_barrier(0);
    f32x16 p1, p0;
#pragma unroll
    for (int r = 0; r < 16; ++r) { p1[r] = 0.f; p0[r] = 0.f; }
#pragma unroll
    for (int dc = 0; dc < 4; ++dc) p1 = __builtin_amdgcn_mfma_f32_32x32x16_bf16(k1[dc], qr[dc], p1, 0, 0, 0);
#pragma unroll
    for (int dc = 0; dc < 4; ++dc) p0 = __builtin_amdgcn_mfma_f32_32x32x16_bf16(k0[dc], qr[dc], p0, 0, 0, 0);
    __builtin_amdgcn_sched_barrier(0);
    u32x4 h1[2], h0[2];
    { f32x16 x;
#pragma unroll
      for (int r = 0; r < 16; ++r) { const float z = fminf(p1[r], 126.f); const float L = __builtin_amdgcn_logf(1.0f + __builtin_amdgcn_exp2f(z)); x[r] = L; p1[r] = z - L; }
#pragma unroll
      for (int s = 0; s < 2; ++s)
#pragma unroll
          for (int i = 0; i < 4; ++i) h1[s][i] = pk(x[8 * s + 2 * i], x[8 * s + 2 * i + 1]); }
    f32x16 y1;
#pragma unroll
    for (int r = 0; r < 16; ++r) y1[r] = carry;
    y1 = __builtin_amdgcn_mfma_f32_32x32x16_bf16(tf[0], __builtin_bit_cast(bf16x8, h1[0]), y1, 0, 0, 0);
    y1 = __builtin_amdgcn_mfma_f32_32x32x16_bf16(tf[1], __builtin_bit_cast(bf16x8, h1[1]), y1, 0, 0, 0);
    __builtin_amdgcn_sched_barrier(0);
    { f32x16 x;
#pragma unroll
      for (int r = 0; r < 16; ++r) { const float z = fminf(p0[r], 126.f); const float L = __builtin_amdgcn_logf(1.0f + __builtin_amdgcn_exp2f(z)); x[r] = L; p0[r] = z - L; }
#pragma unroll
      for (int s = 0; s < 2; ++s)
#pragma unroll
          for (int i = 0; i < 4; ++i) h0[s][i] = pk(x[8 * s + 2 * i], x[8 * s + 2 * i + 1]); }
    __builtin_amdgcn_sched_barrier(0);
    { const float nc = y1[0] + __uint_as_float(h1[0][0] << 16); carry = __shfl(nc, r32); }
    f32x16 y0;
#pragma unroll
    for (int r = 0; r < 16; ++r) y0[r] = carry;
    y0 = __builtin_amdgcn_mfma_f32_32x32x16_bf16(tf[0], __builtin_bit_cast(bf16x8, h0[0]), y0, 0, 0, 0);
    y0 = __builtin_amdgcn_mfma_f32_32x32x16_bf16(tf[1], __builtin_bit_cast(bf16x8, h0[1]), y0, 0, 0, 0);
    const ALDS unsigned char* vb = vbuf + (4 * hi + ((lane & 15) >> 2)) * VSTR + ((lane >> 4) & 1) * 32 + (lane & 3) * 8;
    v4i16 va[2], vb_[2], vc[2], vd[2];
#pragma unroll
    for (int s = 0; s < 2; ++s) { va[s] = vtr(vb + (s + 2) * 16 * VSTR); vb_[s] = vtr(vb + (s + 2) * 16 * VSTR + 8 * VSTR); vc[s] = vtr(vb + (s + 2) * 16 * VSTR + 64); vd[s] = vtr(vb + (s + 2) * 16 * VSTR + 8 * VSTR + 64); }
    __builtin_amdgcn_sched_barrier(0);
    bf16x8 pa2, pa3;
#pragma unroll
    for (int r = 0; r < 16; ++r) p1[r] = __builtin_amdgcn_exp2f(p1[r] - y1[r]);
    pa2 = pack8(p1, 0); pa3 = pack8(p1, 8);
    __builtin_amdgcn_sched_barrier(0);
#pragma unroll
    for (int s = 0; s < 2; ++s) {
        const bf16x8 v0 = (bf16x8){va[s][0], va[s][1], va[s][2], va[s][3], vb_[s][0], vb_[s][1], vb_[s][2], vb_[s][3]}, v1 = (bf16x8){vc[s][0], vc[s][1], vc[s][2], vc[s][3], vd[s][0], vd[s][1], vd[s][2], vd[s][3]};
        o0 = __builtin_amdgcn_mfma_f32_32x32x16_bf16(s ? pa3 : pa2, v0, o0, 0, 0, 0);
        o1 = __builtin_amdgcn_mfma_f32_32x32x16_bf16(s ? pa3 : pa2, v1, o1, 0, 0, 0);
    }
#pragma unroll
    for (int s = 0; s < 2; ++s) { va[s] = vtr(vb + s * 16 * VSTR); vb_[s] = vtr(vb + s * 16 * VSTR + 8 * VSTR); vc[s] = vtr(vb + s * 16 * VSTR + 64); vd[s] = vtr(vb + s * 16 * VSTR + 8 * VSTR + 64); }
    __builtin_amdgcn_sched_barrier(0);
    const bool dead = __all(carry > DEAD_LOG2);
    { const float nc = y0[0] + __uint_as_float(h0[0][0] << 16); carry = __shfl(nc, r32); }
    if (!dead) {
#pragma unroll
        for (int r = 0; r < 16; ++r) p0[r] = __builtin_amdgcn_exp2f(p0[r] - y0[r]);
        const bf16x8 pa0 = pack8(p0, 0), pa1 = pack8(p0, 8);
#pragma unroll
        for (int s = 0; s < 2; ++s) {
            const bf16x8 v0 = (bf16x8){va[s][0], va[s][1], va[s][2], va[s][3], vb_[s][0], vb_[s][1], vb_[s][2], vb_[s][3]}, v1 = (bf16x8){vc[s][0], vc[s][1], vc[s][2], vc[s][3], vd[s][0], vd[s][1], vd[s][2], vd[s][3]};
            o0 = __builtin_amdgcn_mfma_f32_32x32x16_bf16(s ? pa1 : pa0, v0, o0, 0, 0, 0);
            o1 = __builtin_amdgcn_mfma_f32_32x32x16_bf16(s ? pa1 : pa0, v1, o1, 0, 0, 0);
        }
    }
}
template <int MODE, bool MASK>
__device__ __forceinline__ void tile(const ALDS unsigned char* kbuf, const ALDS unsigned char* vbuf, const ALDS float* ckb, const ALDS float* biastab, ALDS float* wsf,
                                     const bf16x8 (&qr)[4], f32x16& o0, f32x16& o1, float& m, float& l, float& carry, const float cq, const int kt, const int qrow,
                                     const int r32, const int hi, const int lane, const bf16x8 (&tf)[2], const bf16x8 ones) {
    if (MODE == SB && !MASK) { sb_tile_pipelined(kbuf, vbuf, qr, o0, o1, carry, r32, hi, lane, tf); return; }
    bf16x8 pa[4];
    tile_qk<MODE, MASK>(kbuf, ckb, biastab, wsf, qr, o0, o1, m, l, carry, cq, kt, qrow, r32, hi, lane, tf, pa);
    tile_pv(vbuf, pa, o0, o1, hi, lane);
}
template <int MODE>
__device__ __forceinline__ void attn_unit(ALDS unsigned char* lds, const AttnArgs& A, const int b, const int h, const int qblk) {
    const int tid = tid_opaque(), lane = tid & 63, r32 = lane & 31, hi = lane >> 5; const int wid = __builtin_amdgcn_readfirstlane(tid >> 6);
    const int q0 = qblk * 256, R = q0 + 32 * wid, qrow = R + r32;
    const size_t rowbase = (size_t)b * S; const int kvp = A.kvp;
    const int kvh = (MODE == SWA) ? (h >> 2) : h;
    const int kt_hi = (q0 >> 6) + 3; int kt_lo = 0; if (MODE == SWA) { kt_lo = (q0 - 128) >> 6; if (kt_lo < 0) kt_lo = 0; }
    const int n = kt_hi - kt_lo + 1;
    const int srow = tid >> 3, sch = tid & 7;
    const bf16_t* ksrc = A.K + (rowbase + srow) * kvp + kvh * 64 + sch * 8;
    const bf16_t* vsrc = A.V + (rowbase + srow) * kvp + kvh * 64 + sch * 8;
    const float* clh = A.cl + (size_t)(b * 16 + h) * S;
    ALDS unsigned char* kdst = lds + OFF_K + srow * KSTR + sch * 16; ALDS unsigned char* vdst = lds + OFF_V + srow * VSTR + sch * 16;
    ALDS float* ckl = (ALDS float*)(lds + OFF_CK); ALDS unsigned* flags = (ALDS unsigned*)(lds + OFF_FLAG);
    ALDS float* wsf = (ALDS float*)(lds + OFF_WSF) + wid * 64; ALDS float* biastab = (ALDS float*)(lds + OFF_BIAS);
    bf16x8 qr[4];
#pragma unroll
    for (int dc = 0; dc < 4; ++dc) qr[dc] = *(const bf16x8*)(A.Q + (rowbase + qrow) * 1024 + h * 64 + dc * 16 + hi * 8);
    if (MODE == SWA) { if (tid < 128) { int bk = tid; if (tid >= 16) { bk = 16 + (int)(logf((float)tid / 16.0f) / logf(8.0f) * 16.0f); if (bk > 31) bk = 31; } biastab[tid] = A.relb[bk * 16 + h] * LOG2E; } }
    f32x16 o0, o1;
#pragma unroll
    for (int r = 0; r < 16; ++r) { o0[r] = 0.f; o1[r] = 0.f; }
    float m = -INFINITY, l = 0.f, carry = 0.f; float cq = 0.f; if (MODE == FOX) cq = clh[qrow];
    bf16x8 tf[2], ones;
#pragma unroll
    for (int j = 0; j < 8; ++j) { ones[j] = (short)0x3F80;
#pragma unroll
        for (int s = 0; s < 2; ++s) { const int jk = 16 * s + 8 * (j >> 2) + 4 * hi + (j & 3); tf[s][j] = (jk > r32) ? (short)0x3F80 : (short)0; } }
    u32x4 kreg, vreg; float ckreg = 0.f, crreg = 0.f;
#define FOX_PAD(d_) ({ const float dh_ = __uint_as_float(pk((d_), 0.f) << 16); (u32x4){pk(-dh_, -((d_) - dh_)), 0u, 0u, 0u}; })
    { const size_t go = (size_t)kt_hi * 64 * kvp; kreg = *(const u32x4*)(ksrc + go); vreg = *(const u32x4*)(vsrc + go); if (MODE == FOX && tid < 64) { ckreg = clh[kt_hi * 64 + tid]; crreg = clh[kt_hi * 64 + 63]; } }
    *(ALDS u32x4*)kdst = kreg; *(ALDS u32x4*)vdst = vreg; if (MODE == FOX && tid < 64) { ckl[tid] = ckreg; *(ALDS u32x4*)(lds + OFF_K + tid * KSTR + 128) = FOX_PAD(ckreg - crreg); }
    __syncthreads();
    bool wdone = false;
    for (int it = 0; it < n; ++it) {
        const int kt = kt_hi - it, buf = it & 1;
        if (it + 1 < n) { const size_t go = (size_t)(kt - 1) * 64 * kvp; kreg = *(const u32x4*)(ksrc + go); vreg = *(const u32x4*)(vsrc + go); if (MODE == FOX && tid < 64) { ckreg = clh[(kt - 1) * 64 + tid]; crreg = clh[(kt - 1) * 64 + 63]; } }
        bool active = (kt * 64 <= R + 31) && !wdone;
        if (MODE == SWA) active = active && (kt * 64 + 63 >= R - 127);
        if (active) {
            const ALDS unsigned char* kbuf = lds + OFF_K + buf * KBUF; const ALDS unsigned char* vbuf = lds + OFF_V + buf * VBUF; const ALDS float* ckb = ckl + buf * 64;
            if (MODE == SWA || kt * 64 + 63 >= R) tile<MODE, true>(kbuf, vbuf, ckb, biastab, wsf, qr, o0, o1, m, l, carry, cq, kt, qrow, r32, hi, lane, tf, ones);
            else tile<MODE, false>(kbuf, vbuf, ckb, biastab, wsf, qr, o0, o1, m, l, carry, cq, kt, qrow, r32, hi, lane, tf, ones);
            if (MODE == SB) wdone = __all(carry > DEAD_LOG2);
        }
        if (MODE == SB) { if (lane == 0) flags[buf * 8 + wid] = wdone ? 1u : 0u; }
        if (it + 1 < n) { *(ALDS u32x4*)(kdst + (buf ^ 1) * KBUF) = kreg; *(ALDS u32x4*)(vdst + (buf ^ 1) * VBUF) = vreg; if (MODE == FOX && tid < 64) { ckl[(buf ^ 1) * 64 + tid] = ckreg; *(ALDS u32x4*)(lds + OFF_K + (buf ^ 1) * KBUF + tid * KSTR + 128) = FOX_PAD(ckreg - crreg); } }
        __syncthreads();
        if (MODE == SB) { unsigned all = 1u;
#pragma unroll
            for (int w = 0; w < 8; ++w) all &= flags[buf * 8 + w];
            if (all) break; }
    }
    float fr[16];
    if (MODE == SB) {
#pragma unroll
        for (int r = 0; r < 16; ++r) fr[r] = 1.f;
    } else {
        float lt = l + __shfl_xor(l, 32);
        if (MODE == SWA) lt += __builtin_amdgcn_exp2f(A.sinks[h] * LOG2E - m);
        const float rl = 1.0f / lt;
        if (hi == 0) wsf[r32] = rl;
#pragma unroll
        for (int r = 0; r < 16; ++r) fr[r] = wsf[crow(r, hi)];
    }
    __hip_bfloat16* Ob = (__hip_bfloat16*)A.O + (rowbase + R) * 1024 + h * 64 + r32;
#pragma unroll
    for (int r = 0; r < 16; ++r) { const int row = crow(r, hi); Ob[(size_t)row * 1024] = __float2bfloat16(o0[r] * fr[r]); Ob[(size_t)row * 1024 + 32] = __float2bfloat16(o1[r] * fr[r]); }
}

constexpr int NSLOT = 5, R_OFF_K = 0, R_OFF_V = NSLOT * KBUF, R_OFF_FLAG = R_OFF_V + NSLOT * VBUF, R_OFF_WSF = R_OFF_FLAG + 64, R_OFF_BIAS = R_OFF_WSF + 8 * 64 * 4, R_LDS_END = R_OFF_BIAS + 512;
static_assert(R_LDS_END <= 131072, "ring fits the phase scratch");
template <int MODE>
__device__ __forceinline__ void attn_unit_ring(ALDS unsigned char* lds, const AttnArgs& A, const int b, const int h, const int qblk) {
    const int tid = tid_opaque(), lane = tid & 63, r32 = lane & 31, hi = lane >> 5; const int wid = __builtin_amdgcn_readfirstlane(tid >> 6);
    const int q0 = qblk * 256, R = q0 + 32 * wid, qrow = R + r32;
    const size_t rowbase = (size_t)b * S; const int kvp = A.kvp;
    const int kvh = (MODE == SWA) ? (h >> 2) : h;
    const int kt_hi = (q0 >> 6) + 3; const int diag = kt_hi - 3 + (wid >> 1);
    const int srow = tid >> 3, sch = tid & 7;
    const bf16_t* ksrc = A.K + (rowbase + srow) * kvp + kvh * 64 + sch * 8;
    const bf16_t* vsrc = A.V + (rowbase + srow) * kvp + kvh * 64 + sch * 8;
    ALDS unsigned char* kdst = lds + R_OFF_K + srow * KSTR + sch * 16; ALDS unsigned char* vdst = lds + R_OFF_V + srow * VSTR + sch * 16;
    ALDS unsigned* flags = (ALDS unsigned*)(lds + R_OFF_FLAG);
    ALDS float* wsf = (ALDS float*)(lds + R_OFF_WSF) + wid * 64; ALDS float* biastab = (ALDS float*)(lds + R_OFF_BIAS);
    bf16x8 qr[4];
#pragma unroll
    for (int dc = 0; dc < 4; ++dc) qr[dc] = *(const bf16x8*)(A.Q + (rowbase + qrow) * 1024 + h * 64 + dc * 16 + hi * 8);
    if (MODE == SWA) { if (tid < 128) { int bk = tid; if (tid >= 16) { bk = 16 + (int)(logf((float)tid / 16.0f) / logf(8.0f) * 16.0f); if (bk > 31) bk = 31; } biastab[tid] = A.relb[bk * 16 + h] * LOG2E; } }
    f32x16 o0, o1;
#pragma unroll
    for (int r = 0; r < 16; ++r) { o0[r] = 0.f; o1[r] = 0.f; }
    float m = -INFINITY, l = 0.f, carry = 0.f;
    bf16x8 tf[2], ones;
#pragma unroll
    for (int j = 0; j < 8; ++j) { ones[j] = (short)0x3F80;
#pragma unroll
        for (int s = 0; s < 2; ++s) { const int jk = 16 * s + 8 * (j >> 2) + 4 * hi + (j & 3); tf[s][j] = (jk > r32) ? (short)0x3F80 : (short)0; } }
    { u32x4 kp[4], vp[4];
#pragma unroll
      for (int tt = 0; tt < 4; ++tt) { const size_t go = (size_t)(kt_hi - tt) * 64 * kvp; kp[tt] = *(const u32x4*)(ksrc + go); vp[tt] = *(const u32x4*)(vsrc + go); }
      __builtin_amdgcn_sched_barrier(0);
#pragma unroll
      for (int tt = 0; tt < 4; ++tt) { const int sl = (kt_hi - tt) % NSLOT; *(ALDS u32x4*)(kdst + sl * KBUF) = kp[tt]; *(ALDS u32x4*)(vdst + sl * VBUF) = vp[tt]; } }
    __syncthreads();
    bool wdone = false;
    for (int j = 0;; ++j) {
        const int tp = kt_hi - 4 - j; u32x4 kreg, vreg;
        if (tp >= 0) { const size_t go = (size_t)tp * 64 * kvp; kreg = *(const u32x4*)(ksrc + go); vreg = *(const u32x4*)(vsrc + go); }
        const int kt = diag - j;
        bool active = (kt >= 0) && !wdone;
        if (MODE == SWA) active = active && (kt * 64 + 63 >= R - 127);
        if (active) {
            const int sl = kt % NSLOT;
            const ALDS unsigned char* kbuf = lds + R_OFF_K + sl * KBUF; const ALDS unsigned char* vbuf = lds + R_OFF_V + sl * VBUF;
            if (MODE == SWA || j == 0) tile<MODE, true>(kbuf, vbuf, (const ALDS float*)nullptr, biastab, wsf, qr, o0, o1, m, l, carry, 0.f, kt, qrow, r32, hi, lane, tf, ones);
            else tile<MODE, false>(kbuf, vbuf, (const ALDS float*)nullptr, biastab, wsf, qr, o0, o1, m, l, carry, 0.f, kt, qrow, r32, hi, lane, tf, ones);
            if (MODE == SB) wdone = __all(carry > DEAD_LOG2);
        }
        bool fin = wdone || (kt - 1 < 0);
        if (MODE == SWA) fin = fin || ((kt - 1) * 64 + 63 < R - 127);
        if (lane == 0) flags[(j & 1) * 8 + wid] = fin ? 1u : 0u;
        if (tp >= 0) { const int sl = tp % NSLOT; *(ALDS u32x4*)(kdst + sl * KBUF) = kreg; *(ALDS u32x4*)(vdst + sl * VBUF) = vreg; }
        __syncthreads();
        unsigned all = 1u;
#pragma unroll
        for (int w = 0; w < 8; ++w) all &= flags[(j & 1) * 8 + w];
        if (all) break;
    }
    float fr[16];
    if (MODE == SB) {
#pragma unroll
        for (int r = 0; r < 16; ++r) fr[r] = 1.f;
    } else {
        float lt = l + __shfl_xor(l, 32);
        if (MODE == SWA) lt += __builtin_amdgcn_exp2f(A.sinks[h] * LOG2E - m);
        const float rl = 1.0f / lt;
        if (hi == 0) wsf[r32] = rl;
#pragma unroll
        for (int r = 0; r < 16; ++r) fr[r] = wsf[crow(r, hi)];
    }
    __hip_bfloat16* Ob = (__hip_bfloat16*)A.O + (rowbase + R) * 1024 + h * 64 + r32;
#pragma unroll
    for (int r = 0; r < 16; ++r) { const int row = crow(r, hi); Ob[(size_t)row * 1024] = __float2bfloat16(o0[r] * fr[r]); Ob[(size_t)row * 1024 + 32] = __float2bfloat16(o1[r] * fr[r]); }
}

constexpr int F_OFF_K = 0, F_OFF_V = 4 * KBUF, F_OFF_CK = F_OFF_V + 4 * VBUF, F_OFF_WSF = F_OFF_CK + 1024, F_OFF_FLAG = F_OFF_WSF + 8 * 64 * 4, F_LDS_END = F_OFF_FLAG + 64;
static_assert(F_LDS_END <= 131072, "FoX stage buffers fit the phase scratch");
__device__ __forceinline__ void fox_pair_fast(const ALDS unsigned char* kbufA, const ALDS unsigned char* kbufB, const ALDS unsigned char* vbufA, const ALDS unsigned char* vbufB,
                                              const ALDS float* ckbA, const ALDS float* ckbB, ALDS float* wsf, const bf16x8 (&qr)[4], f32x16& o0, f32x16& o1, float& m, float& l,
                                              const float cq, const int r32, const int hi, const int lane) {
    const float base = cq - m, cinA = base - ckbA[63], cinB = base - ckbB[63];
    f32x16 a0, a1, b0, b1;
#pragma unroll
    for (int r = 0; r < 16; ++r) { a0[r] = cinA; a1[r] = cinA; b0[r] = cinB; b1[r] = cinB; }
    const ALDS unsigned char* ka = kbufA + r32 * KSTR + hi * 16; const ALDS unsigned char* kb = kbufB + r32 * KSTR + hi * 16;
    { bf16x8 qa; qa[0] = hi ? (short)0 : (short)0x3F80; qa[1] = qa[0]; qa[2] = 0; qa[3] = 0; qa[4] = 0; qa[5] = 0; qa[6] = 0; qa[7] = 0;
      const ALDS unsigned char* pa_ = kbufA + r32 * KSTR + 128; const ALDS unsigned char* pb_ = kbufB + r32 * KSTR + 128;
      bf16x8 fa0[5], fa1[5], fb0[5], fb1[5];
#pragma unroll
      for (int dc = 0; dc < 4; ++dc) { fa0[dc] = *(const ALDS bf16x8*)(ka + dc * 32); fa1[dc] = *(const ALDS bf16x8*)(ka + 32 * KSTR + dc * 32); }
      fa0[4] = *(const ALDS bf16x8*)pa_; fa1[4] = *(const ALDS bf16x8*)(pa_ + 32 * KSTR);
#pragma unroll
      for (int dc = 0; dc < 4; ++dc) { fb0[dc] = *(const ALDS bf16x8*)(kb + dc * 32); fb1[dc] = *(const ALDS bf16x8*)(kb + 32 * KSTR + dc * 32); }
      fb0[4] = *(const ALDS bf16x8*)pb_; fb1[4] = *(const ALDS bf16x8*)(pb_ + 32 * KSTR);
      __builtin_amdgcn_sched_barrier(0);
#pragma unroll
      for (int dc = 0; dc < 4; ++dc) { a0 = __builtin_amdgcn_mfma_f32_32x32x16_bf16(fa0[dc], qr[dc], a0, 0, 0, 0); a1 = __builtin_amdgcn_mfma_f32_32x32x16_bf16(fa1[dc], qr[dc], a1, 0, 0, 0); }
      a0 = __builtin_amdgcn_mfma_f32_32x32x16_bf16(fa0[4], qa, a0, 0, 0, 0); a1 = __builtin_amdgcn_mfma_f32_32x32x16_bf16(fa1[4], qa, a1, 0, 0, 0);
#pragma unroll
      for (int dc = 0; dc < 4; ++dc) { b0 = __builtin_amdgcn_mfma_f32_32x32x16_bf16(fb0[dc], qr[dc], b0, 0, 0, 0); b1 = __builtin_amdgcn_mfma_f32_32x32x16_bf16(fb1[dc], qr[dc], b1, 0, 0, 0); }
      b0 = __builtin_amdgcn_mfma_f32_32x32x16_bf16(fb0[4], qa, b0, 0, 0, 0); b1 = __builtin_amdgcn_mfma_f32_32x32x16_bf16(fb1[4], qa, b1, 0, 0, 0); }
    float mq[4];
#pragma unroll
    for (int r = 0; r < 4; ++r) mq[r] = fmaxf(fmaxf(a0[r], a1[r]), fmaxf(b0[r], b1[r]));
#pragma unroll
    for (int r = 4; r < 16; ++r) mq[r & 3] = fmaxf(mq[r & 3], fmaxf(fmaxf(a0[r], a1[r]), fmaxf(b0[r], b1[r])));
    float mx = fmaxf(fmaxf(mq[0], mq[1]), fmaxf(mq[2], mq[3]));
    { auto rr = __builtin_amdgcn_permlane32_swap(__float_as_uint(mx), __float_as_uint(mx), false, false); mx = fmaxf(__uint_as_float(rr[0]), __uint_as_float(rr[1])); }
    if (__any(mx > RESCALE_THR)) {
        const float d = fmaxf(mx, 0.f); m += d; const float f = __builtin_amdgcn_exp2f(-d); l *= f;
        if (hi == 0) wsf[r32] = f;
#pragma unroll
        for (int r = 0; r < 16; ++r) { const float fr = wsf[crow(r, hi)]; o0[r] *= fr; o1[r] *= fr; a0[r] -= d; a1[r] -= d; b0[r] -= d; b1[r] -= d; }
    }
    float lq[4] = {0.f, 0.f, 0.f, 0.f};
#pragma unroll
    for (int r = 0; r < 16; ++r) { a0[r] = __builtin_amdgcn_exp2f(a0[r]); a1[r] = __builtin_amdgcn_exp2f(a1[r]); b0[r] = __builtin_amdgcn_exp2f(b0[r]); b1[r] = __builtin_amdgcn_exp2f(b1[r]); lq[r & 3] += (a0[r] + a1[r]) + (b0[r] + b1[r]); }
    l += (lq[0] + lq[1]) + (lq[2] + lq[3]);
    bf16x8 pA[4], pB[4];
    pA[0] = pack8(a0, 0); pA[1] = pack8(a0, 8); pA[2] = pack8(a1, 0); pA[3] = pack8(a1, 8);
    pB[0] = pack8(b0, 0); pB[1] = pack8(b0, 8); pB[2] = pack8(b1, 0); pB[3] = pack8(b1, 8);
    tile_pv(vbufA, pA, o0, o1, hi, lane);
    tile_pv(vbufB, pB, o0, o1, hi, lane);
}
__device__ __forceinline__ void attn_unit_fox(ALDS unsigned char* lds, const AttnArgs& A, const int b, const int h, const int qblk) {
    const int tid = tid_opaque(), lane = tid & 63, r32 = lane & 31, hi = lane >> 5; const int wid = __builtin_amdgcn_readfirstlane(tid >> 6);
    const int q0 = qblk * 256, R = q0 + 32 * wid, qrow = R + r32;
    const size_t rowbase = (size_t)b * S; const int kvp = A.kvp;
    const int kt_hi = (q0 >> 6) + 3, npairs = (kt_hi + 1) >> 1;
    const int srow = tid >> 3, sch = tid & 7;
    const bf16_t* ksrc = A.K + (rowbase + srow) * kvp + h * 64 + sch * 8;
    const bf16_t* vsrc = A.V + (rowbase + srow) * kvp + h * 64 + sch * 8;
    const float* clh = A.cl + (size_t)(b * 16 + h) * S;
    ALDS unsigned char* kdst = lds + F_OFF_K + srow * KSTR + sch * 16; ALDS unsigned char* vdst = lds + F_OFF_V + srow * VSTR + sch * 16;
    ALDS float* ckl = (ALDS float*)(lds + F_OFF_CK); ALDS float* wsf = (ALDS float*)(lds + F_OFF_WSF) + wid * 64;
    bf16x8 qr[4];
#pragma unroll
    for (int dc = 0; dc < 4; ++dc) qr[dc] = *(const bf16x8*)(A.Q + (rowbase + qrow) * 1024 + h * 64 + dc * 16 + hi * 8);
    f32x16 o0, o1;
#pragma unroll
    for (int r = 0; r < 16; ++r) { o0[r] = 0.f; o1[r] = 0.f; }
    float m = -INFINITY, l = 0.f, carry = 0.f; const float cq = clh[qrow];
    bf16x8 tf[2] = {}, ones = {};
    float qn2 = 0.f;
#pragma unroll
    for (int dc = 0; dc < 4; ++dc)
#pragma unroll
        for (int e = 0; e < 8; ++e) { const float qv = __uint_as_float(((unsigned)(unsigned short)qr[dc][e]) << 16); qn2 += qv * qv; }
    qn2 += __shfl_xor(qn2, 32);
    const float sbound = sqrtf(qn2) * sqrtf(__uint_as_float(A.kmax2[b * 16 + h])) * 1.01f + 1.0f;
    ALDS unsigned* flags = (ALDS unsigned*)(lds + F_OFF_FLAG);
    bool wdone = false;
    u32x4 kA, vA, kB, vB; float ckA = 0.f, crA = 0.f, ckB = 0.f, crB = 0.f;
#define FX_LOAD(j_) do { const int tA_ = kt_hi - 2 * (j_); const size_t gA_ = (size_t)tA_ * 64 * kvp, gB_ = (size_t)(tA_ - 1) * 64 * kvp; \
        kA = *(const u32x4*)(ksrc + gA_); vA = *(const u32x4*)(vsrc + gA_); kB = *(const u32x4*)(ksrc + gB_); vB = *(const u32x4*)(vsrc + gB_); \
        if (tid < 64) { ckA = clh[tA_ * 64 + tid]; crA = clh[tA_ * 64 + 63]; ckB = clh[(tA_ - 1) * 64 + tid]; crB = clh[(tA_ - 1) * 64 + 63]; } } while (0)
#define FX_WRITE(pb_) do { const int sA_ = 2 * (pb_), sB_ = sA_ + 1; \
        *(ALDS u32x4*)(kdst + sA_ * KBUF) = kA; *(ALDS u32x4*)(vdst + sA_ * VBUF) = vA; *(ALDS u32x4*)(kdst + sB_ * KBUF) = kB; *(ALDS u32x4*)(vdst + sB_ * VBUF) = vB; \
        if (tid < 64) { ckl[sA_ * 64 + tid] = ckA; ckl[sB_ * 64 + tid] = ckB; \
            *(ALDS u32x4*)(lds + F_OFF_K + sA_ * KBUF + tid * KSTR + 128) = FOX_PAD(ckA - crA); *(ALDS u32x4*)(lds + F_OFF_K + sB_ * KBUF + tid * KSTR + 128) = FOX_PAD(ckB - crB); } } while (0)
    FX_LOAD(0); FX_WRITE(0);
    __syncthreads();
    for (int j = 0; j < npairs; ++j) {
        const int pb = j & 1, tA = kt_hi - 2 * j, tB = tA - 1;
        if (j + 1 < npairs) FX_LOAD(j + 1);
        const ALDS unsigned char* kbA = lds + F_OFF_K + (2 * pb) * KBUF; const ALDS unsigned char* kbB = kbA + KBUF;
        const ALDS unsigned char* vbA = lds + F_OFF_V + (2 * pb) * VBUF; const ALDS unsigned char* vbB = vbA + VBUF;
        const ALDS float* ckbA = ckl + (2 * pb) * 64; const ALDS float* ckbB = ckbA + 64;
        const bool actA = (tA * 64 <= R + 31) && !wdone, actB = (tB * 64 <= R + 31) && !wdone;
        if (actA && (tA * 64 + 63 < R) && __all(sbound + (cq - ckbA[63] - m) < -DEAD_LOG2)) wdone = true;
        else if (actA && (tA * 64 + 63 < R)) fox_pair_fast(kbA, kbB, vbA, vbB, ckbA, ckbB, wsf, qr, o0, o1, m, l, cq, r32, hi, lane);
        else {
            if (actA) tile<FOX, true>(kbA, vbA, ckbA, (const ALDS float*)nullptr, wsf, qr, o0, o1, m, l, carry, cq, tA, qrow, r32, hi, lane, tf, ones);
            if (actB) { if (tB * 64 + 63 >= R) tile<FOX, true>(kbB, vbB, ckbB, (const ALDS float*)nullptr, wsf, qr, o0, o1, m, l, carry, cq, tB, qrow, r32, hi, lane, tf, ones);
                        else tile<FOX, false>(kbB, vbB, ckbB, (const ALDS float*)nullptr, wsf, qr, o0, o1, m, l, carry, cq, tB, qrow, r32, hi, lane, tf, ones); }
        }
        if (lane == 0) flags[pb * 8 + wid] = wdone ? 1u : 0u;
        if (j + 1 < npairs) FX_WRITE(pb ^ 1);
        __syncthreads();
        { unsigned all = 1u;
#pragma unroll
          for (int w = 0; w < 8; ++w) all &= flags[pb * 8 + w];
          if (all) break; }
    }
#undef FX_LOAD
#undef FX_WRITE
    const float lt = l + __shfl_xor(l, 32); const float rl = 1.0f / lt;
    if (hi == 0) wsf[r32] = rl;
    float fr[16];
#pragma unroll
    for (int r = 0; r < 16; ++r) fr[r] = wsf[crow(r, hi)];
    __hip_bfloat16* Ob = (__hip_bfloat16*)A.O + (rowbase + R) * 1024 + h * 64 + r32;
#pragma unroll
    for (int r = 0; r < 16; ++r) { const int row = crow(r, hi); Ob[(size_t)row * 1024] = __float2bfloat16(o0[r] * fr[r]); Ob[(size_t)row * 1024 + 32] = __float2bfloat16(o1[r] * fr[r]); }
}
template <int MODE>
__device__ __forceinline__ void attn_phase(ALDS unsigned char* lds, const AttnArgs& A, const int vcu, const int G) {
    if (MODE == FOX) {
        ALDS unsigned* qslot = (ALDS unsigned*)(lds + 131072 + 512);
        unsigned nxt = 0u;
        if (tid_opaque() == 0) qslot[0] = atomicAdd(A.qctr, 1u);
        __syncthreads();
        unsigned u = qslot[0];
        while (u < 2048u) {
            if (tid_opaque() == 0) nxt = atomicAdd(A.qctr, 1u);
            const int bh = (int)(u & 127u), qb = 15 - (int)(u >> 7);
            attn_unit_fox(lds, A, bh >> 4, bh & 15, qb);
            if (tid_opaque() == 0) qslot[0] = nxt;
            __syncthreads();
            u = qslot[0];
        }
        return;
    }
    for (int pi = vcu; pi < 1024; pi += G) { const int bh = pi >> 3, j = pi & 7;
        if (MODE == FOX) { attn_unit_fox(lds, A, bh >> 4, bh & 15, j); attn_unit_fox(lds, A, bh >> 4, bh & 15, 15 - j); }
        else { attn_unit_ring<MODE>(lds, A, bh >> 4, bh & 15, j); attn_unit_ring<MODE>(lds, A, bh >> 4, bh & 15, 15 - j); } }
}
}

typedef unsigned short bf16;
typedef float f32x4 __attribute__((ext_vector_type(4)));
typedef unsigned v4u __attribute__((ext_vector_type(4)));
#define LAS __attribute__((address_space(3)))
constexpr int NB = 8, SEQ = 4096, M = NB * SEQ, D = 1024, FF = 4096, PD = 256, DEPTH = 4;
constexpr int LDS_BYTES = 147456;
constexpr size_t MiB = 1u << 20;
constexpr size_t WS_W = 0;
constexpr size_t WL_STRIDE = 27 * MiB, WL_IN = 0, WL_OUT = 6 * MiB + 512 * 1024, WL_UP = WL_OUT + 2 * MiB, WL_DOWN = WL_UP + 8 * MiB, WL_PLE = WL_DOWN + 8 * MiB, WL_GATE = WL_PLE + 512 * 1024;
constexpr size_t WS_HB = 108 * MiB;
constexpr size_t WS_Q = 172 * MiB, WS_K = WS_Q + 64 * MiB, WS_V = WS_K + 64 * MiB, WS_O = WS_V + 64 * MiB;
constexpr size_t WS_A = WS_Q;
constexpr size_t WS_SCR = WS_Q;
constexpr size_t WS_PB = 428 * MiB;
constexpr size_t WS_SSQ = 450 * MiB;
constexpr size_t WS_LF = 446 * MiB, WS_CL = 448 * MiB, WS_BAR = 476 * MiB, BAR_BYTES = 16384, KMAX_OFF = 14336, QCTR_OFF = 15360, WS_END = 477 * MiB;

#define XB_TMO      128
#define XB_XCNT(j)  (256  + 64 * (j))
#define XB_XSUB(j)  (1280 + 64 * (j))
#define XB_XGEN(j)  (2304 + 64 * (j))
#define XB_TOP      3328
#define XB_TOPGEN   3392
#define XCD_BAR_WORDS 3456
#define XB_SPIN_CAP (1u << 18)

__device__ __forceinline__ unsigned xb_ld(unsigned* p)              { return __hip_atomic_load(p, __ATOMIC_RELAXED, __HIP_MEMORY_SCOPE_AGENT); }
__device__ __forceinline__ unsigned xb_add(unsigned* p, unsigned v) { return __hip_atomic_fetch_add(p, v, __ATOMIC_RELAXED, __HIP_MEMORY_SCOPE_AGENT); }
__device__ __forceinline__ unsigned xb_xcc_id() { return (unsigned)__builtin_amdgcn_s_getreg((3 << 11) | 20) & 0xFu; }
#define XB_SPIN(cond, bar) do { unsigned _sp = 0; while (cond) { __builtin_amdgcn_s_sleep(1); \
    if ((++_sp & 255u) == 0u) { if (xb_ld(&(bar)[XB_TMO])) break; if (_sp > XB_SPIN_CAP) { atomicAdd(&(bar)[XB_TMO], 1u); break; } } } } while (0)

struct XcdBarrier {
    unsigned* bar; unsigned x;
    volatile LAS unsigned* st;
};

__device__ __forceinline__ XcdBarrier xcd_barrier_post(unsigned* bar, volatile LAS unsigned* st) {
    XcdBarrier b; b.bar = bar; b.x = xb_xcc_id(); b.st = st;
    if (threadIdx.x == 0) (void)xb_add(&bar[XB_XCNT(b.x)], 1u);
    return b;
}
__device__ __forceinline__ void xcd_barrier_complete(unsigned* bar, unsigned x, unsigned& nloc, unsigned& nx) {
    const unsigned G = gridDim.x * gridDim.y * gridDim.z;
    unsigned sum, cnt, mine, sp = 0u;
    for (;;) {
        sum = 0u; cnt = 0u; mine = 0u;
#pragma unroll
        for (unsigned j = 0; j < 16; ++j) { const unsigned c = xb_ld(&bar[XB_XCNT(j)]); sum += c; cnt += (c > 0u) ? 1u : 0u; mine = (j == x) ? c : mine; }
        if (sum == G) break;
        __builtin_amdgcn_s_sleep(1);
        if ((++sp & 255u) == 0u) { if (xb_ld(&bar[XB_TMO])) break; if (sp > XB_SPIN_CAP) { atomicAdd(&bar[XB_TMO], 1u); break; } }
    }
    nloc = mine > 0u ? mine : 1u; nx = cnt > 0u ? cnt : 1u;
}

__device__ __forceinline__ void xcd_barrier(const XcdBarrier& b) {
    asm volatile("s_waitcnt vmcnt(0)" ::: "memory");
    __syncthreads();
    if (threadIdx.x == 0) {
        unsigned* bar = b.bar;
        __builtin_amdgcn_s_waitcnt(0);
        unsigned nloc = b.st[0], nx = b.st[1];
        if (nloc == 0u) { xcd_barrier_complete(bar, b.x, nloc, nx); b.st[0] = nloc; b.st[1] = nx; }
        const unsigned old = xb_add(&bar[XB_XSUB(b.x)], 1u);
        const unsigned gen = old / nloc;
        if (old + 1u == (gen + 1u) * nloc) {
            __builtin_amdgcn_fence(__ATOMIC_RELEASE, "agent");
            asm volatile("s_waitcnt vmcnt(0)" ::: "memory");
            const unsigned og = xb_add(&bar[XB_TOP], 1u);
            const unsigned tg = og / nx;
            if (og + 1u == (tg + 1u) * nx) xb_add(&bar[XB_TOPGEN], 1u);
            else XB_SPIN(xb_ld(&bar[XB_TOPGEN]) == tg, bar);
            __builtin_amdgcn_fence(__ATOMIC_ACQUIRE, "agent");
            xb_add(&bar[XB_XGEN(b.x)], 1u);
            asm volatile("s_waitcnt vmcnt(0)" ::: "memory");
        } else {
            XB_SPIN(xb_ld(&bar[XB_XGEN(b.x)]) == gen, bar);
            __builtin_amdgcn_fence(__ATOMIC_ACQUIRE, "agent");
            asm volatile("s_waitcnt vmcnt(0)" ::: "memory");
        }
    }
    __syncthreads();
}

struct Args { const float* in[19]; float* out; unsigned char* ws; };

__device__ __forceinline__ unsigned f2bf(float f) { unsigned u = __builtin_bit_cast(unsigned, f); return (u + 0x7fffu + ((u >> 16) & 1u)) >> 16; }
__device__ __forceinline__ unsigned pk2(float lo, float hi) { return f2bf(lo) | (f2bf(hi) << 16); }
__device__ __forceinline__ float wave_sum(float v) {
#pragma unroll
    for (int o = 1; o < 64; o <<= 1) v += __shfl_xor(v, o);
    return v;
}
__device__ __forceinline__ void transpose_item(const float* W, int K, int ld, int Nvalid, int Npad, const float* gain, bf16* WT, LAS float* scr, int item, int lane) {
    const int nblk = Npad / 32, kb = item / nblk, nb = item % nblk, k0 = 64 * kb, n0 = 32 * nb;
    const int c = n0 + (lane & 31);
#pragma unroll 8
    for (int i = 0; i < 32; ++i) { const int kk = 2 * i + (lane >> 5); float v = 0.f; if (c < Nvalid) { v = W[(size_t)(k0 + kk) * ld + c]; if (gain) v *= gain[k0 + kk]; } scr[kk * 33 + (lane & 31)] = v; }
    asm volatile("s_waitcnt lgkmcnt(0)" ::: "memory");
    const int ch = lane & 7;
#pragma unroll
    for (int j = 0; j < 4; ++j) { const int n = (lane >> 3) + 8 * j; const LAS float* s = scr + (8 * ch) * 33 + n;
        v4u o; o.x = pk2(s[0 * 33], s[1 * 33]); o.y = pk2(s[2 * 33], s[3 * 33]); o.z = pk2(s[4 * 33], s[5 * 33]); o.w = pk2(s[6 * 33], s[7 * 33]);
        *(v4u*)(WT + (size_t)(n0 + n) * K + k0 + 8 * ch) = o; }
    asm volatile("s_waitcnt lgkmcnt(0)" ::: "memory");
}
__device__ __forceinline__ void transpose_mat(const float* W, int K, int ld, int Nvalid, int Npad, const float* gain, bf16* WT, LAS float* scr, int gw, int NGW, int lane) {
    const int nitems = (K / 64) * (Npad / 32);
    for (int it = gw; it < nitems; it += NGW) transpose_item(W, K, ld, Nvalid, Npad, gain, WT, scr, it, lane);
}

#define GRID_SYNC() do { asm volatile("s_waitcnt vmcnt(0) lgkmcnt(0)" ::: "memory"); grid.sync(); asm volatile("buffer_inv sc1\n\ts_waitcnt vmcnt(0)" ::: "memory"); } while (0)
__device__ __forceinline__ void transpose_mat_wg(const float* W, int K, int ld, int Nvalid, int Npad, const float* gain, bf16* WT, LAS float* tile, int wg, int nwg, int tid) {
    const int nblk = Npad >> 6, nitems = (K >> 6) * nblk;
    const int lr = tid >> 4, lc = (tid & 15) * 4, n = tid & 63, c = __builtin_amdgcn_readfirstlane(tid >> 6);
    int it = wg; if (it >= nitems) return;
    f32x4 v0, v1;
#define TR_LOAD(item) do { const int kb_ = (item) / nblk, nb_ = (item) - kb_ * nblk; const int col_ = (nb_ << 6) + lc; const float* src_ = W + (size_t)((kb_ << 6) + lr) * ld + col_; \
        if (col_ < Nvalid) { v0 = *(const f32x4*)src_; v1 = *(const f32x4*)(src_ + (size_t)32 * ld); } else { v0 = (f32x4){0.f, 0.f, 0.f, 0.f}; v1 = v0; } } while (0)
    TR_LOAD(it);
    for (;;) {
        const int kb = it / nblk, nb = it - kb * nblk, k0 = kb << 6, n0 = nb << 6;
        __syncthreads();
        *(LAS f32x4*)(tile + lr * 68 + lc) = v0; *(LAS f32x4*)(tile + (lr + 32) * 68 + lc) = v1;
        __syncthreads();
        const int nxt = it + nwg; const bool more = nxt < nitems;
        if (more) TR_LOAD(nxt);
        float t[8];
#pragma unroll
        for (int j = 0; j < 8; ++j) { t[j] = tile[(8 * c + j) * 68 + n]; if (gain) t[j] *= gain[k0 + 8 * c + j]; }
        v4u o; o.x = pk2(t[0], t[1]); o.y = pk2(t[2], t[3]); o.z = pk2(t[4], t[5]); o.w = pk2(t[6], t[7]);
        *(v4u*)(WT + (size_t)(n0 + n) * K + k0 + 8 * c) = o;
        if (!more) break;
        it = nxt;
    }
#undef TR_LOAD
}

__global__ void __launch_bounds__(512, 2) mega_fwd(Args args) {
    extern __shared__ __attribute__((aligned(16))) unsigned char lds_raw[];
    cg::grid_group grid = cg::this_grid();
    LAS unsigned char* lds = (LAS unsigned char*)lds_raw;
    const int G = gridDim.x, bx = blockIdx.x; const int vcu = (G % 8 == 0) ? (bx % 8) * (G / 8) + bx / 8 : bx;
    const int NGW = G * 8, NGT = G * 512;
#define tid tid_opaque()
#define lane (tid_opaque() & 63)
#define wave __builtin_amdgcn_readfirstlane(tid_opaque() >> 6)
#define gw (vcu * 8 + wave)
#define gt (bx * 512 + tid_opaque())
    unsigned char* ws = args.ws;
    { volatile LAS unsigned* misc = (volatile LAS unsigned*)(lds + 131072); if (tid < 32) misc[tid] = 0u; }
    __syncthreads();
    const XcdBarrier xbar = xcd_barrier_post((unsigned*)(ws + WS_BAR), (volatile LAS unsigned*)(lds + 131072));
#define OPQ(p_) ({ auto q_ = (p_); asm volatile("" : "+s"(q_)); q_; })
#define OPQ0() ({ int z_ = 0; asm volatile("" : "+s"(z_)); z_; })
#define KIN(k_) (args.in[k_] + OPQ0())
#define WSP(off_) (ws + (size_t)(off_) + OPQ0())
#define XIN KIN(0)
#define PIN KIN(1)
#define attn_norm KIN(2)
#define mlp_norm KIN(3)
#define ple_norm KIN(4)
#define final_norm KIN(5)
#define w_in_sb KIN(6)
#define w_out_sb KIN(7)
#define w_in_fox KIN(8)
#define b_forget KIN(9)
#define w_out_fox KIN(10)
#define w_in_swa KIN(11)
#define sinks KIN(12)
#define w_out_swa KIN(13)
#define rel_bias KIN(14)
#define w_up KIN(15)
#define w_down KIN(16)
#define w_ple KIN(17)
#define w_gate KIN(18)
#define hout (args.out + OPQ0())
#define HB0 ((bf16*)WSP(WS_HB))
#define HB1 ((bf16*)(args.out + OPQ0()))
#define HBF ((bf16*)WSP(WS_O))
#define QB ((bf16*)WSP(WS_Q))
#define KB ((bf16*)WSP(WS_K))
#define VB ((bf16*)WSP(WS_V))
#define OB ((bf16*)WSP(WS_O))
#define AB ((bf16*)WSP(WS_A))
#define SCR ((float*)WSP(WS_SCR))
#define PB ((bf16*)WSP(WS_PB))
#define SSQ ((float*)WSP(WS_SSQ))
#define LF ((float*)WSP(WS_LF))
#define CL ((float*)WSP(WS_CL))

    { const float* xin = XIN; bf16* hb1 = HB1; float* ssq0 = SSQ; const int ln = lane, gw0 = gw;
      for (int mrow = gw0; mrow < M; mrow += 2 * NGW) {
        const int mrow2 = (mrow + NGW < M) ? mrow + NGW : mrow;
        const f32x4* xr = (const f32x4*)(xin + (size_t)mrow * D) + ln; const f32x4* xr2 = (const f32x4*)(xin + (size_t)mrow2 * D) + ln;
        f32x4 v[4], w[4];
#pragma unroll
        for (int j = 0; j < 4; ++j) { v[j] = xr[64 * j]; w[j] = xr2[64 * j]; }
        unsigned long long* o8 = (unsigned long long*)(hb1 + (size_t)mrow * D) + ln; unsigned long long* o82 = (unsigned long long*)(hb1 + (size_t)mrow2 * D) + ln;
        float s1 = 0.f, s2 = 0.f;
#pragma unroll
        for (int j = 0; j < 4; ++j) { s1 += (v[j].x * v[j].x + v[j].y * v[j].y) + (v[j].z * v[j].z + v[j].w * v[j].w); s2 += (w[j].x * w[j].x + w[j].y * w[j].y) + (w[j].z * w[j].z + w[j].w * w[j].w);
            o8[64 * j] = (unsigned long long)pk2(v[j].x, v[j].y) | ((unsigned long long)pk2(v[j].z, v[j].w) << 32);
            o82[64 * j] = (unsigned long long)pk2(w[j].x, w[j].y) | ((unsigned long long)pk2(w[j].z, w[j].w) << 32); }
        s1 = wave_sum(s1); s2 = wave_sum(s2);
        if (ln == 0) { f32x4* sp = (f32x4*)(ssq0 + (size_t)mrow * 16); sp[0] = (f32x4){s1, 0.f, 0.f, 0.f}; sp[1] = (f32x4){0.f, 0.f, 0.f, 0.f}; sp[2] = (f32x4){0.f, 0.f, 0.f, 0.f}; sp[3] = (f32x4){0.f, 0.f, 0.f, 0.f};
                       f32x4* sq = (f32x4*)(ssq0 + (size_t)mrow2 * 16); sq[0] = (f32x4){s2, 0.f, 0.f, 0.f}; sq[1] = (f32x4){0.f, 0.f, 0.f, 0.f}; sq[2] = (f32x4){0.f, 0.f, 0.f, 0.f}; sq[3] = (f32x4){0.f, 0.f, 0.f, 0.f}; }
      } }
    {
        LAS float* scr = (LAS float*)lds;
#pragma unroll 1
        for (int i = 0; i < DEPTH; ++i) {
            const int kind = i % 3, j = i / 3; unsigned char* wl = ws + WS_W + (size_t)i * WL_STRIDE;
            if (kind == 0) transpose_mat_wg(w_in_sb + (size_t)j * D * 3072, D, 3072, 3072, 3072, attn_norm + i * D, (bf16*)(wl + WL_IN), scr, vcu, G, tid);
            else if (kind == 1) transpose_mat_wg(w_in_fox, D, 3088, 3088, 3328, attn_norm + i * D, (bf16*)(wl + WL_IN), scr, vcu, G, tid);
            else transpose_mat_wg(w_in_swa, D, 1536, 1536, 1536, attn_norm + i * D, (bf16*)(wl + WL_IN), scr, vcu, G, tid);
            const float* wo = kind == 0 ? w_out_sb + (size_t)j * D * D : (kind == 1 ? w_out_fox : w_out_swa);
            transpose_mat_wg(wo, D, D, D, D, nullptr, (bf16*)(wl + WL_OUT), scr, vcu, G, tid);
            transpose_mat_wg(w_up + (size_t)i * D * FF, D, FF, FF, FF, mlp_norm + i * D, (bf16*)(wl + WL_UP), scr, vcu, G, tid);
            transpose_mat_wg(w_down + (size_t)i * FF * D, FF, D, D, D, nullptr, (bf16*)(wl + WL_DOWN), scr, vcu, G, tid);
            transpose_mat_wg(w_ple + (size_t)i * PD * D, PD, D, D, D, nullptr, (bf16*)(wl + WL_PLE), scr, vcu, G, tid);
            transpose_mat_wg(w_gate + (size_t)i * D * D, D, D, D, D, ple_norm + i * D, (bf16*)(wl + WL_GATE), scr, vcu, G, tid);
        }
    }
    __syncthreads();
    GRID_SYNC();

    const float C2 = 0.125f * 1.4426950408889634f;
#pragma unroll 1
    for (int i = 0; i < DEPTH; ++i) {
        const int kind = i % 3; unsigned char* wl = ws + WS_W + (size_t)i * WL_STRIDE;
        bf16* hb_next = (i == DEPTH - 1) ? HBF : HB1;
        { const f32x4* ps = (const f32x4*)(PIN + (size_t)i * M * PD); unsigned long long* pd = (unsigned long long*)PB; const int gt0 = gt;
          for (int e = gt0; e < M * PD / 4; e += 4 * NGT) {
              f32x4 v4[4];
#pragma unroll
              for (int q = 0; q < 4; ++q) { const int idx = (e + q * NGT < M * PD / 4) ? e + q * NGT : e; v4[q] = ps[idx]; }
#pragma unroll
              for (int q = 0; q < 4; ++q) { const int idx = (e + q * NGT < M * PD / 4) ? e + q * NGT : e; pd[idx] = (unsigned long long)pk2(v4[q].x, v4[q].y) | ((unsigned long long)pk2(v4[q].z, v4[q].w) << 32); } } }
        {
            const int N = kind == 0 ? 3072 : (kind == 1 ? 3328 : 1536);
            pg8::Gemm g{HB1, (const bf16*)(wl + WL_IN), M, N, D}; pg8::StaticOrder S; S.init(M, N, G, bx);
            epi::EpiQkv E{SSQ + (size_t)(3 * i) * M * 16, QB, KB, VB, kind == 2 ? 1 : 4, kind == 2 ? 256 : 1024, C2, LF, b_forget};
#ifndef X_NOQKV
            epi::fill_rstd(E.ssq, S);
            pg8::gemm_phase<epi::EpiQkv, pg8::StaticOrder, true, true>(lds, g, S, E);
#endif
        }
        xcd_barrier(xbar);
        if (kind == 1) {
            { const float* lf0 = LF; float* cl0 = CL; const int ln = lane, gw0 = gw;
              for (int seq = gw0; seq < NB * 16; seq += NGW) { const int b = seq >> 4, h = seq & 15;
                const float* src = lf0 + ((size_t)b * SEQ + 4 * ln) * 16 + h; float* dst = cl0 + (size_t)seq * SEQ + 4 * ln;
                float v[16][4];
#pragma unroll
                for (int c = 0; c < 16; ++c)
#pragma unroll
                    for (int i = 0; i < 4; ++i) v[c][i] = src[(size_t)(c * 256 + i) * 16];
                float carry = 0.f;
#pragma unroll
                for (int c = 0; c < 16; ++c) {
                    const float a1 = v[c][0] + v[c][1], a2 = a1 + v[c][2], a3 = a2 + v[c][3];
                    float incl = a3;
#pragma unroll
                    for (int o = 1; o < 64; o <<= 1) { const float t = __shfl_up(incl, o); if (ln >= o) incl += t; }
                    const float base = carry + (incl - a3);
                    f32x4 outv = {base + v[c][0], base + a1, base + a2, base + a3};
                    *(f32x4*)(dst + c * 256) = outv * 1.4426950408889634f;
                    carry = __shfl(base + a3, 63);
                } }
              { const bf16* kb0 = KB; unsigned* km = (unsigned*)(WSP(WS_BAR) + KMAX_OFF);
                for (int seg = gw0; seg < NB * 16 * 16; seg += NGW) { const int bh = seg >> 4, part = seg & 15; const int b = bh >> 4, h = bh & 15;
                    const bf16* kp = kb0 + ((size_t)b * SEQ + part * 256 + 4 * ln) * 1024 + h * 64; float best = 0.f;
#pragma unroll
                    for (int r = 0; r < 4; ++r) { float ss = 0.f;
#pragma unroll
                        for (int c = 0; c < 8; ++c) { const v4u w = *(const v4u*)(kp + (size_t)r * 1024 + c * 8);
#pragma unroll
                            for (int e = 0; e < 4; ++e) { const float lo = __uint_as_float(w[e] << 16), hi2 = __uint_as_float(w[e] & 0xffff0000u); ss += lo * lo + hi2 * hi2; } }
                        best = fmaxf(best, ss); }
#pragma unroll
                    for (int o = 1; o < 64; o <<= 1) best = fmaxf(best, __shfl_xor(best, o));
                    if (ln == 0) atomicMax(km + bh, __float_as_uint(best)); } } }
            xcd_barrier(xbar);
        }
        {
            att::AttnArgs A{QB, KB, VB, OB, kind == 2 ? 256 : 1024, CL, rel_bias, sinks, (const unsigned*)(WSP(WS_BAR) + KMAX_OFF), (unsigned*)(WSP(WS_BAR) + QCTR_OFF)};
#ifndef X_NOSB
            if (kind == 0) att::attn_phase<att::SB>(lds, A, vcu, G);
#endif
#ifndef X_NOFOX
            if (kind == 1) att::attn_phase<att::FOX>(lds, A, vcu, G);
#endif
#ifndef X_NOSWA
            if (kind == 2) att::attn_phase<att::SWA>(lds, A, vcu, G);
#endif
        }
        xcd_barrier(xbar);
        {
            pg8::Gemm g{OB, (const bf16*)(wl + WL_OUT), M, D, D}; pg8::StaticOrder S; S.init(M, D, G, bx);
            epi::EpiRes<0> E{HB1, HB0, SSQ + (size_t)(3 * i + 1) * M * 16, nullptr, nullptr};
#ifndef X_NORES1
            pg8::gemm_phase<epi::EpiRes<0>, pg8::StaticOrder, true, true>(lds, g, S, E);
#endif
        }
        xcd_barrier(xbar);
        {
            pg8::Gemm g{HB0, (const bf16*)(wl + WL_UP), M, FF, D}; pg8::StaticOrder S; S.init(M, FF, G, bx);
            epi::EpiAct<1> E{SSQ + (size_t)(3 * i + 1) * M * 16, AB, FF};
#ifndef X_NOUP
            epi::fill_rstd(E.ssq, S);
            pg8::gemm_phase<epi::EpiAct<1>, pg8::StaticOrder, true, true>(lds, g, S, E);
#endif
        }
        xcd_barrier(xbar);
        {
            pg8::Gemm g{AB, (const bf16*)(wl + WL_DOWN), M, D, FF}; pg8::StaticOrder S; S.init(M, D, G, bx);
            epi::EpiRes<0> E{HB0, HB0, SSQ + (size_t)(3 * i + 2) * M * 16, nullptr, nullptr};
#ifndef X_NORES2
            pg8::gemm_phase<epi::EpiRes<0>, pg8::StaticOrder, true, true>(lds, g, S, E);
#endif
        }
        xcd_barrier(xbar);
        {
            int Kp = PD; asm volatile("" : "+s"(Kp));
            pg8::Gemm g{PB, (const bf16*)(wl + WL_PLE), M, D, Kp}; pg8::StaticOrder S; S.init(M, D, G, bx);
            epi::EpiDump E{SCR};
#ifndef X_NODUMP
            pg8::gemm_phase<epi::EpiDump, pg8::StaticOrder, true, true>(lds, g, S, E);
#endif
        }
        {
            pg8::Gemm g{HB0, (const bf16*)(wl + WL_GATE), M, D, D}; pg8::StaticOrder S; S.init(M, D, G, bx);
            epi::EpiRes<1> E{HB0, hb_next, SSQ + (size_t)(3 * i + 3) * M * 16, SSQ + (size_t)(3 * i + 2) * M * 16, SCR};
#ifndef X_NOGATE
            epi::fill_rstd(E.ssq_in, S);
            pg8::gemm_phase<epi::EpiRes<1>, pg8::StaticOrder, true, true>(lds, g, S, E);
#endif
        }
        xcd_barrier(xbar);
    }
    const float* ssqF = SSQ + (size_t)12 * M * 16; const bf16* hbf = HBF; float* outp = hout; const float* fng = final_norm; const int lnF = lane, gwF = gw;
    for (int mrow = gwF; mrow < M; mrow += 2 * NGW) {
        const int mrow2 = (mrow + NGW < M) ? mrow + NGW : mrow;
        const float rs = epi::rstd_of(ssqF, mrow), rs2 = epi::rstd_of(ssqF, mrow2);
        const unsigned long long* hr = (const unsigned long long*)(hbf + (size_t)mrow * D) + lnF; const unsigned long long* hr2 = (const unsigned long long*)(hbf + (size_t)mrow2 * D) + lnF;
        f32x4* orow = (f32x4*)(outp + (size_t)mrow * D) + lnF; f32x4* orow2 = (f32x4*)(outp + (size_t)mrow2 * D) + lnF; const f32x4* gr = (const f32x4*)fng + lnF;
        unsigned long long w1[4], w2[4]; f32x4 g[4];
#pragma unroll
        for (int j = 0; j < 4; ++j) { w1[j] = hr[64 * j]; w2[j] = hr2[64 * j]; g[j] = gr[64 * j]; }
#pragma unroll
        for (int j = 0; j < 4; ++j) {
            { const unsigned lo = (unsigned)w1[j], hi2 = (unsigned)(w1[j] >> 32); const f32x4 v = {__uint_as_float(lo << 16), __uint_as_float(lo & 0xffff0000u), __uint_as_float(hi2 << 16), __uint_as_float(hi2 & 0xffff0000u)}; orow[64 * j] = v * rs * g[j]; }
            { const unsigned lo = (unsigned)w2[j], hi2 = (unsigned)(w2[j] >> 32); const f32x4 v = {__uint_as_float(lo << 16), __uint_as_float(lo & 0xffff0000u), __uint_as_float(hi2 << 16), __uint_as_float(hi2 & 0xffff0000u)}; orow2[64 * j] = v * rs2 * g[j]; } }
    }
}

#undef tid
#undef lane
#undef wave
#undef gw
#undef gt
#undef XIN
#undef PIN
#undef attn_norm
#undef mlp_norm
#undef ple_norm
#undef final_norm
#undef w_in_sb
#undef w_out_sb
#undef w_in_fox
#undef b_forget
#undef w_out_fox
#undef w_in_swa
#undef sinks
#undef w_out_swa
#undef rel_bias
#undef w_up
#undef w_down
#undef w_ple
#undef w_gate
#undef hout
#undef HB0
#undef HB1
#undef HBF
#undef QB
#undef KB
#undef VB
#undef OB
#undef AB
#undef SCR
#undef PB
#undef SSQ
#undef LF
#undef CL
extern "C" void kernel_launch(void* const* d_in, const int* in_sizes, int n_in, void* d_out, int out_size, void* d_ws, size_t ws_size, hipStream_t stream) {
    static int grid = 0;
    if (grid == 0) {
        if (n_in != 19 || out_size != M * D || ws_size < WS_END) { fprintf(stderr, "kernel_launch: unexpected shapes (n_in %d out %d ws %zu)\n", n_in, out_size, ws_size); grid = -1; return; }
        int dev = 0, cus = 0, per_cu = 0;
        (void)hipGetDevice(&dev);
        (void)hipDeviceGetAttribute(&cus, hipDeviceAttributeMultiprocessorCount, dev);
        if (hipFuncSetAttribute((const void*)mega_fwd, hipFuncAttributeMaxDynamicSharedMemorySize, LDS_BYTES) != hipSuccess) fprintf(stderr, "kernel_launch: hipFuncSetAttribute failed\n");
        if (hipOccupancyMaxActiveBlocksPerMultiprocessor(&per_cu, (const void*)mega_fwd, 512, LDS_BYTES) != hipSuccess || per_cu < 1) { fprintf(stderr, "kernel_launch: occupancy query gave %d\n", per_cu); per_cu = 1; }
        (void)hipGetLastError();
        grid = cus;
    }
    if (grid < 0) return;
    if (hipMemsetAsync((unsigned char*)d_ws + WS_BAR, 0, BAR_BYTES, stream) != hipSuccess) { fprintf(stderr, "kernel_launch: memset of the barrier words failed\n"); return; }
    Args a{};
    for (int i = 0; i < 19; ++i) a.in[i] = (const float*)d_in[i];
    a.out = (float*)d_out; a.ws = (unsigned char*)d_ws;
    void* kargs[] = {&a};
    const hipError_t e = hipLaunchCooperativeKernel((const void*)mega_fwd, dim3(grid), dim3(512), kargs, LDS_BYTES, stream);
    if (e != hipSuccess) fprintf(stderr, "kernel_launch: cooperative launch failed: %s (grid %d)\n", hipGetErrorString(e), grid);
}
```

```cpp
#include <hip/hip_runtime.h>
#include <hip/hip_cooperative_groups.h>
#include <hip/hip_bf16.h>
#include <cstdio>
#include <cstdint>
#include <cmath>
namespace cg = cooperative_groups;
__device__ __forceinline__ int tid_opaque() { int t = (int)threadIdx.x; asm volatile("" : "+v"(t)); return t; }
namespace pg8 {
#define PG8_LAS __attribute__((address_space(3)))
typedef unsigned short bf16_t;
typedef short bf16x8 __attribute__((ext_vector_type(8)));
typedef float f32x4 __attribute__((ext_vector_type(4)));
typedef unsigned u32x4 __attribute__((ext_vector_type(4)));
constexpr int BM = 256, BK = 64, HALF = 128, HTB = HALF * BK * 2  , STAGE_BYTES = 8 * HTB, NXCD = 8, WGM = 8;

__host__ __device__ __forceinline__ int lds_byte(int r, int c) { const int st = (r >> 4) * 2 + (c >> 5), rr = r & 15, cc = c & 31, ob = rr * 64 + cc * 2; return st * 1024 + (ob ^ (((ob >> 9) & 1) << 5)); }
__host__ __device__ __forceinline__ void stage_rc(int b, int& R, int& C) { const int st = b / 1024, sb = b % 1024, swz = sb ^ (((sb >> 9) & 1) << 5); R = (st >> 1) * 16 + swz / 64; C = (st & 1) * 32 + (swz % 64) / 2; }
__host__ __device__ __forceinline__ int perm32(int rho) { const int n = rho >> 4, i = rho & 15; return 8 * (i >> 2) + 4 * n + (i & 3); }

struct Unit { int pm, pn, idx; };
struct Gemm { const bf16_t* A; const bf16_t* Bt; int M, N, K; };

struct StaticOrder {
    int nM, nN, nwg, G, c;
    __host__ __device__ void init(int M, int N, int G_, int c_) { nM = M / BM; nN = N / BM; nwg = nM * nN; G = G_; c = c_; }
    __host__ __device__ bool next(int i, Unit& u) const {
        const long L = (long)i * G + c; if (L >= nwg) return false;
        int wgid = (int)L; { const int q = nwg / NXCD, r = nwg % NXCD, xcd = wgid % NXCD, off = wgid / NXCD; wgid = (xcd < r ? xcd * (q + 1) : r * (q + 1) + (xcd - r) * q) + off; }
        const int nig = WGM * nN, gid = wgid / nig, fm = gid * WGM, gsz = (nM - fm) < WGM ? (nM - fm) : WGM;
        u.pm = fm + ((wgid % nig) % gsz); u.pn = (wgid % nig) / gsz; u.idx = i; return true;
    }
    __device__ __forceinline__ void a_ready(const Unit&) const {}
    __device__ __forceinline__ void done(const Unit&) const {}
};
__device__ __forceinline__ unsigned cvt_pk_bf16(float lo, float hi) { unsigned r; asm volatile("v_cvt_pk_bf16_f32 %0, %1, %2" : "=v"(r) : "v"(lo), "v"(hi)); return r; }
typedef float f32x2 __attribute__((ext_vector_type(2)));
template <class Epi, class Sched, bool ALIGN_EPI = false, bool SP2 = false>
__device__ __forceinline__ void gemm_phase(PG8_LAS unsigned char* lds, const Gemm g, const Sched& S, const Epi& E) {
    const int tid = tid_opaque(), wid = __builtin_amdgcn_readfirstlane(tid >> 6), lane = tid & 63, wr = wid >> 2, wc = wid & 3, fr = lane & 15, fq = lane >> 4;
    const int K = g.K, nt = K / BK;
    unsigned voffA[2], voffB[2];
#pragma unroll
    for (int i = 0; i < 2; ++i) { int R, C; stage_rc(tid * 16 + i * 8192, R, C); const int Rb = Epi::PERM ? ((R & ~31) + perm32(R & 31)) : R;
        voffA[i] = (unsigned)(R * K + C) * 2u; voffB[i] = (unsigned)(Rb * K + C) * 2u; }
    const size_t kstep = (size_t)(BK * 2);
    const size_t hstep = (size_t)HALF * K * 2;
    const size_t tstep = 2 * hstep;
    const unsigned ldsw = (unsigned)wid * 1024u;
    const int aoff = lds_byte(wr * 64 + fr, fq * 8), boff = lds_byte(wc * 32 + fr, fq * 8);
#define PG8_SA(b, h) (((b) * 2 + (h)) * HTB)
#define PG8_SB(b, h) ((4 + (b) * 2 + (h)) * HTB)
#define PG8_STAGE(bufoff, gbase, voff) do { _Pragma("unroll") for (int _i = 0; _i < 2; ++_i) \
        __builtin_amdgcn_global_load_lds((const unsigned*)((const char*)(gbase) + (voff)[_i]), (PG8_LAS unsigned*)(lds + (bufoff) + ldsw + _i * 8192), 16, 0, 0); } while (0)
#define PG8_LDA(dst, b, h) do { _Pragma("unroll") for (int m = 0; m < 4; ++m) _Pragma("unroll") for (int k = 0; k < 2; ++k) dst[m][k] = *(const PG8_LAS bf16x8*)(lds + PG8_SA(b, h) + aoff + m * 2048 + k * 1024); } while (0)
#define PG8_LDB(dst, b, h) do { _Pragma("unroll") for (int n = 0; n < 2; ++n) _Pragma("unroll") for (int k = 0; k < 2; ++k) dst[n][k] = *(const PG8_LAS bf16x8*)(lds + PG8_SB(b, h) + boff + n * 2048 + k * 1024); } while (0)
#define PG8_MMA(ai, bj, At, Bt) do { __builtin_amdgcn_s_setprio(1); _Pragma("unroll") for (int m = 0; m < 4; ++m) _Pragma("unroll") for (int n = 0; n < 2; ++n) _Pragma("unroll") for (int k = 0; k < 2; ++k) \
        acc[ai][bj][m][n] = __builtin_amdgcn_mfma_f32_16x16x32_bf16(Bt[n][k], At[m][k], acc[ai][bj][m][n], 0, 0, 0); __builtin_amdgcn_s_setprio(0); } while (0)
#define PG8_WAIT_V(n) asm volatile("s_waitcnt vmcnt(" #n ")" ::: "memory")
#define PG8_WAIT_L(n) asm volatile("s_waitcnt lgkmcnt(" #n ")" ::: "memory")
#define PG8_BAR __builtin_amdgcn_s_barrier()
#define PG8_SCHED __builtin_amdgcn_sched_barrier(0)
    Unit cur, nxt; int ui = 0;
    if (!S.next(0, cur)) return;
    f32x4 acc[2][2][4][2];
#pragma unroll
    for (int a = 0; a < 2; ++a)
#pragma unroll
        for (int b = 0; b < 2; ++b)
#pragma unroll
            for (int m = 0; m < 4; ++m)
#pragma unroll
                for (int n = 0; n < 2; ++n) acc[a][b][m][n] = (f32x4){0.f, 0.f, 0.f, 0.f};
    bf16x8 At[4][2], B0[2][2], B1[2][2];
    const char* cA = (const char*)g.A + (size_t)cur.pm * tstep; const char* cB = (const char*)g.Bt + (size_t)cur.pn * tstep;
    S.a_ready(cur);
    if constexpr (SP2) {
        PG8_STAGE(PG8_SB(0, 0), cB, voffB); PG8_STAGE(PG8_SB(0, 1), cB + hstep, voffB); PG8_STAGE(PG8_SA(0, 0), cA, voffA); PG8_STAGE(PG8_SA(0, 1), cA + hstep, voffA);
        if (wr == 1) PG8_BAR;
        PG8_WAIT_V(2); PG8_BAR;
        PG8_STAGE(PG8_SB(1, 0), cB + kstep, voffB); PG8_STAGE(PG8_SA(1, 0), cA + kstep, voffA); PG8_STAGE(PG8_SB(1, 1), cB + hstep + kstep, voffB);
        PG8_WAIT_V(6); PG8_BAR;
    } else {
        PG8_STAGE(PG8_SB(0, 0), cB, voffB); PG8_STAGE(PG8_SA(0, 0), cA, voffA); PG8_STAGE(PG8_SB(0, 1), cB + hstep, voffB); PG8_STAGE(PG8_SA(0, 1), cA + hstep, voffA);
        if (wr == 1) PG8_BAR;
        PG8_WAIT_V(4); PG8_BAR;
        PG8_STAGE(PG8_SB(1, 0), cB + kstep, voffB); PG8_STAGE(PG8_SA(1, 0), cA + kstep, voffA); PG8_STAGE(PG8_SB(1, 1), cB + hstep + kstep, voffB);
        PG8_WAIT_V(6); PG8_BAR;
    }
    for (;;) {
        const bool has_next = S.next(ui + 1, nxt);
        const char* nA = has_next ? (const char*)g.A + (size_t)nxt.pm * tstep : cA; const char* nB = has_next ? (const char*)g.Bt + (size_t)nxt.pn * tstep : cB;
        for (int t = 0; t < nt; t += 2) {
            const bool last = (t == nt - 2);
            const char* a1 = cA + (size_t)(t + 1) * kstep;
            const char* a2 = last ? nA : cA + (size_t)(t + 2) * kstep; const char* b2 = last ? nB : cB + (size_t)(t + 2) * kstep;
            const char* a3 = a2 + kstep; const char* b3 = b2 + kstep;
            if (last && has_next) S.a_ready(nxt);
            if constexpr (SP2) {
            PG8_LDB(B0, 0, 0); PG8_LDB(B1, 0, 1); PG8_SCHED; PG8_LDA(At, 0, 0); PG8_STAGE(PG8_SA(1, 1), a1 + hstep, voffA);
            PG8_WAIT_V(8); PG8_WAIT_L(0); PG8_BAR; PG8_MMA(0, 0, At, B0); PG8_MMA(0, 1, At, B1); PG8_BAR; PG8_SCHED;
            PG8_LDA(At, 0, 1); PG8_STAGE(PG8_SB(0, 0), b2, voffB); PG8_STAGE(PG8_SB(0, 1), b2 + hstep, voffB); PG8_STAGE(PG8_SA(0, 0), a2, voffA);
            PG8_WAIT_V(8); PG8_WAIT_L(0); PG8_BAR; PG8_MMA(1, 0, At, B0); PG8_MMA(1, 1, At, B1); PG8_BAR; PG8_SCHED;
            PG8_LDB(B0, 1, 0); PG8_LDB(B1, 1, 1); PG8_SCHED; PG8_LDA(At, 1, 0); PG8_STAGE(PG8_SA(0, 1), a2 + hstep, voffA);
            PG8_WAIT_V(8); PG8_WAIT_L(0); PG8_BAR; PG8_MMA(0, 0, At, B0); PG8_MMA(0, 1, At, B1); PG8_BAR; PG8_SCHED;
            PG8_LDA(At, 1, 1); PG8_STAGE(PG8_SB(1, 0), b3, voffB); PG8_STAGE(PG8_SB(1, 1), b3 + hstep, voffB); PG8_STAGE(PG8_SA(1, 0), a3, voffA);
            PG8_WAIT_V(8); PG8_WAIT_L(0); PG8_BAR; PG8_MMA(1, 0, At, B0); PG8_MMA(1, 1, At, B1); PG8_BAR; PG8_SCHED;
            } else {
            PG8_LDB(B0, 0, 0); PG8_SCHED; PG8_LDA(At, 0, 0); PG8_STAGE(PG8_SA(1, 1), a1 + hstep, voffA);
            PG8_WAIT_L(8); PG8_BAR; PG8_WAIT_L(0); PG8_MMA(0, 0, At, B0); PG8_BAR; PG8_SCHED;
            PG8_LDB(B1, 0, 1); PG8_STAGE(PG8_SB(0, 0), b2, voffB);
            PG8_BAR; PG8_WAIT_L(0); PG8_MMA(0, 1, At, B1); PG8_BAR;
            PG8_LDA(At, 0, 1); PG8_STAGE(PG8_SA(0, 0), a2, voffA);
            PG8_BAR; PG8_WAIT_L(0); PG8_MMA(1, 0, At, B0); PG8_BAR; PG8_SCHED;
            PG8_STAGE(PG8_SB(0, 1), b2 + hstep, voffB);
            PG8_WAIT_V(6); PG8_BAR; PG8_MMA(1, 1, At, B1); PG8_BAR;
            PG8_LDB(B0, 1, 0); PG8_SCHED; PG8_LDA(At, 1, 0); PG8_STAGE(PG8_SA(0, 1), a2 + hstep, voffA);
            PG8_WAIT_L(8); PG8_BAR; PG8_WAIT_L(0); PG8_MMA(0, 0, At, B0); PG8_BAR; PG8_SCHED;
            PG8_LDB(B1, 1, 1); PG8_STAGE(PG8_SB(1, 0), b3, voffB);
            PG8_BAR; PG8_WAIT_L(0); PG8_MMA(0, 1, At, B1); PG8_BAR;
            PG8_LDA(At, 1, 1); PG8_STAGE(PG8_SA(1, 0), a3, voffA);
            PG8_BAR; PG8_WAIT_L(0); PG8_MMA(1, 0, At, B0); PG8_BAR; PG8_SCHED;
            PG8_STAGE(PG8_SB(1, 1), b3 + hstep, voffB);
            PG8_WAIT_V(6); PG8_BAR; PG8_MMA(1, 1, At, B1); PG8_BAR;
            }
        }
        if constexpr (ALIGN_EPI) { if (wr == 0) PG8_BAR; }
        if constexpr (!Epi::AFTER_DRAIN) { E(acc, cur, wr, wc, fr, fq); S.done(cur); }
        if (!has_next) break;
#pragma unroll
        for (int a = 0; a < 2; ++a)
#pragma unroll
            for (int b = 0; b < 2; ++b)
#pragma unroll
                for (int m = 0; m < 4; ++m)
#pragma unroll
                    for (int n = 0; n < 2; ++n) acc[a][b][m][n] = (f32x4){0.f, 0.f, 0.f, 0.f};
        cur = nxt; cA = nA; cB = nB; ++ui;
        if constexpr (ALIGN_EPI) { if (wr == 1) PG8_BAR; }
    }
    PG8_WAIT_V(0);
    if constexpr (!ALIGN_EPI) { if (wr == 0) PG8_BAR; }
    PG8_BAR;
    if constexpr (Epi::AFTER_DRAIN) { E.fused(acc, cur, wr, wc, fr, fq, lds, wid, lane); S.done(cur); }
#undef PG8_SA
#undef PG8_SB
#undef PG8_STAGE
#undef PG8_LDA
#undef PG8_LDB
#undef PG8_MMA
#undef PG8_WAIT_V
#undef PG8_WAIT_L
#undef PG8_BAR
#undef PG8_SCHED
}
}

namespace epi {
using pg8::f32x4; using pg8::u32x4; using pg8::bf16_t; using pg8::Unit; using pg8::cvt_pk_bf16; using pg8::BM; using pg8::HALF;
typedef unsigned u32x2 __attribute__((ext_vector_type(2)));
constexpr float EPS = 1e-6f, LOG2E = 1.4426950408889634f;
__device__ __forceinline__ float rstd_of(const float* ssq, int row) { const f32x4* p = (const f32x4*)(ssq + (size_t)row * 16); const f32x4 a = p[0], b = p[1], c = p[2], d = p[3];
    const float s = (((a[0] + a[1]) + (a[2] + a[3])) + ((b[0] + b[1]) + (b[2] + b[3]))) + (((c[0] + c[1]) + (c[2] + c[3])) + ((d[0] + d[1]) + (d[2] + d[3]))); return rsqrtf(s * (1.0f / 1024.0f) + EPS); }

constexpr int RSTD_LDS_OFF = 131072 + 1024;
__device__ __forceinline__ float rstd_lds(const Unit& u, int row) { return ((const __attribute__((address_space(3))) float*)(RSTD_LDS_OFF))[u.idx * 256 + (row & 255)]; }
template <class Sched> __device__ __forceinline__ void fill_rstd(const float* ssq, const Sched& S) {
    const int tid = tid_opaque(); Unit u;
    if (tid < 256) { for (int i = 0; S.next(i, u); ++i) ((__attribute__((address_space(3))) float*)(RSTD_LDS_OFF))[i * 256 + tid] = rstd_of(ssq, u.pm * BM + tid); }
    __syncthreads();
}
struct EpiQkv {
    static constexpr bool PERM = true, AFTER_DRAIN = false;
    const float* ssq; bf16_t *q, *k, *v; int nk, kvp; float qscale; float* lf; const float* bfor;
    __device__ __forceinline__ void operator()(const f32x4 (&acc)[2][2][4][2], const Unit& u, int wr, int wc, int fr, int fq) const {
        const int row0 = u.pm * BM + wr * 64 + fr; const int pn = u.pn;
        if (pn >= 4 + 2 * nk) {
            if (wc == 0 && fq < 2) {
#pragma unroll
                for (int ai = 0; ai < 2; ++ai)
#pragma unroll
                    for (int m = 0; m < 4; ++m) { const int row = row0 + ai * HALF + m * 16; const float rs = rstd_lds(u, row);
#pragma unroll
                        for (int n = 0; n < 2; ++n) { const int c = 8 * fq + 4 * n; const f32x4 a = acc[ai][0][m][n]; f32x4 o;
#pragma unroll
                            for (int i = 0; i < 4; ++i) { const float x = a[i] * rs + bfor[c + i]; o[i] = fminf(x, 0.f) - 0.6931471805599453f * __builtin_amdgcn_logf(1.0f + __builtin_amdgcn_exp2f(-LOG2E * fabsf(x))); }
                            *(f32x4*)(lf + (size_t)row * 16 + c) = o; } }
            }
            return;
        }
        bf16_t* base; int pitch, colt; float sc = 1.f;
        if (pn < 4) { base = q; pitch = 1024; colt = pn * 256; sc = qscale; }
        else if (pn < 4 + nk) { base = k; pitch = kvp; colt = (pn - 4) * 256; }
        else { base = v; pitch = kvp; colt = (pn - 4 - nk) * 256; }
        const int col0 = colt + wc * 32 + 8 * fq;
#pragma unroll
        for (int ai = 0; ai < 2; ++ai)
#pragma unroll
            for (int m = 0; m < 4; ++m) { const int row = row0 + ai * HALF + m * 16; const float rs = rstd_lds(u, row) * sc; bf16_t* rowp = base + (size_t)row * pitch + col0;
#pragma unroll
                for (int bj = 0; bj < 2; ++bj) { const f32x4 v0 = acc[ai][bj][m][0] * rs, v1 = acc[ai][bj][m][1] * rs; u32x4 w;
                    w.x = cvt_pk_bf16(v0[0], v0[1]); w.y = cvt_pk_bf16(v0[2], v0[3]); w.z = cvt_pk_bf16(v1[0], v1[1]); w.w = cvt_pk_bf16(v1[2], v1[3]);
                    *(u32x4*)(rowp + bj * HALF) = w; }
                asm volatile("" ::: "memory"); }
    }
};
template <int ACT> struct EpiAct {
    static constexpr bool PERM = true, AFTER_DRAIN = false;
    const float* ssq; bf16_t* O; int ldc;
    __device__ __forceinline__ void operator()(const f32x4 (&acc)[2][2][4][2], const Unit& u, int wr, int wc, int fr, int fq) const {
        const int row0 = u.pm * BM + wr * 64 + fr; const int col0 = u.pn * BM + wc * 32 + 8 * fq;
#pragma unroll
        for (int ai = 0; ai < 2; ++ai)
#pragma unroll
            for (int m = 0; m < 4; ++m) { const int row = row0 + ai * HALF + m * 16; const float rs = rstd_lds(u, row); bf16_t* rowp = O + (size_t)row * ldc + col0;
#pragma unroll
                for (int bj = 0; bj < 2; ++bj) { f32x4 v0 = acc[ai][bj][m][0] * rs, v1 = acc[ai][bj][m][1] * rs;
                    if (ACT == 1) {
#pragma unroll
                        for (int i = 0; i < 4; ++i) { const float a = __builtin_amdgcn_fmed3f(v0[i], 0.f, 3.0e38f), b = __builtin_amdgcn_fmed3f(v1[i], 0.f, 3.0e38f); v0[i] = a * a; v1[i] = b * b; } }
                    u32x4 w; w.x = cvt_pk_bf16(v0[0], v0[1]); w.y = cvt_pk_bf16(v0[2], v0[3]); w.z = cvt_pk_bf16(v1[0], v1[1]); w.w = cvt_pk_bf16(v1[2], v1[3]);
                    *(u32x4*)(rowp + bj * HALF) = w; }
                asm volatile("" ::: "memory"); }
    }
};
struct EpiDump {
    static constexpr bool PERM = true, AFTER_DRAIN = false;
    float* scr;
    __device__ __forceinline__ void operator()(const f32x4 (&acc)[2][2][4][2], const Unit& u, int wr, int wc, int fr, int fq) const {
        typedef __attribute__((address_space(1))) u32x4 gu32x4;
        gu32x4* p = (gu32x4*)((u32x4*)scr + (size_t)(u.pm * 4 + u.pn) * 16 * 512 + tid_opaque() * 2);
#pragma unroll
        for (int ai = 0; ai < 2; ++ai)
#pragma unroll
            for (int m = 0; m < 4; ++m) {
#pragma unroll
                for (int bj = 0; bj < 2; ++bj) { const f32x4 v0 = acc[ai][bj][m][0], v1 = acc[ai][bj][m][1]; u32x4 w;
                    w.x = cvt_pk_bf16(v0[0], v0[1]); w.y = cvt_pk_bf16(v0[2], v0[3]); w.z = cvt_pk_bf16(v1[0], v1[1]); w.w = cvt_pk_bf16(v1[2], v1[3]); p[bj] = w; }
                p += 1024; asm volatile("" : "+v"(p) :: "memory"); }
    }
};
template <int GATE> struct EpiRes {
    static constexpr bool PERM = true, AFTER_DRAIN = false;
    const bf16_t* hin; bf16_t* hb; float* ssq_out; const float* ssq_in; const float* scr;
    __device__ __forceinline__ void operator()(const f32x4 (&acc)[2][2][4][2], const Unit& u, int wr, int wc, int fr, int fq) const {
        const int row0 = u.pm * BM + wr * 64 + fr; const int col0 = u.pn * BM + wc * 32 + 8 * fq;
        typedef __attribute__((address_space(1))) const u32x4 gcu32x4;
        gcu32x4* sp = (gcu32x4*)((const u32x4*)scr + (size_t)(u.pm * 4 + u.pn) * 16 * 512 + tid_opaque() * 2);
#pragma unroll
        for (int ai = 0; ai < 2; ++ai)
#pragma unroll
            for (int m = 0; m < 4; ++m) { const int row = row0 + ai * HALF + m * 16; const size_t off = (size_t)row * 1024 + col0; float part = 0.f;
                float rs = 0.f; if (GATE) rs = rstd_lds(u, row) * (-LOG2E);
#pragma unroll
                for (int bj = 0; bj < 2; ++bj) { const u32x4 hw = *(const u32x4*)(hin + off + bj * HALF); u32x4 pw; if (GATE) pw = sp[bj]; u32x4 wout;
#pragma unroll
                    for (int n = 0; n < 2; ++n) { const unsigned h0 = n ? hw.z : hw.x, h1 = n ? hw.w : hw.y;
                        f32x4 hv = {__uint_as_float(h0 << 16), __uint_as_float(h0 & 0xffff0000u), __uint_as_float(h1 << 16), __uint_as_float(h1 & 0xffff0000u)}; f32x4 a = acc[ai][bj][m][n];
                        if (GATE) { const unsigned w0 = n ? pw.z : pw.x, w1 = n ? pw.w : pw.y; const f32x4 pe = {__uint_as_float(w0 << 16), __uint_as_float(w0 & 0xffff0000u), __uint_as_float(w1 << 16), __uint_as_float(w1 & 0xffff0000u)};
#pragma unroll
                            for (int i = 0; i < 4; ++i) a[i] = pe[i] * __builtin_amdgcn_rcpf(1.0f + __builtin_amdgcn_exp2f(a[i] * rs)); }
                        hv += a;
                        const unsigned o0_ = cvt_pk_bf16(hv[0], hv[1]), o1_ = cvt_pk_bf16(hv[2], hv[3]);
                        if (n) { wout.z = o0_; wout.w = o1_; } else { wout.x = o0_; wout.y = o1_; }
                        part += (hv[0] * hv[0] + hv[1] * hv[1]) + (hv[2] * hv[2] + hv[3] * hv[3]); }
                    *(u32x4*)(hb + off + bj * HALF) = wout; }
                { auto r1 = __builtin_amdgcn_permlane16_swap(__float_as_uint(part), __float_as_uint(part), false, false); part = __uint_as_float(r1[0]) + __uint_as_float(r1[1]);
                  auto r2 = __builtin_amdgcn_permlane32_swap(__float_as_uint(part), __float_as_uint(part), false, false); part = __uint_as_float(r2[0]) + __uint_as_float(r2[1]); }
                if (fq == 0) ssq_out[(size_t)row * 16 + u.pn * 4 + wc] = part;
                if (GATE) { sp += 1024; asm volatile("" : "+v"(sp)); }
                if (GATE ? (m & 1) : (m == 3)) asm volatile("" ::: "memory"); }
    }
};
}

namespace att {
typedef unsigned short bf16_t;
typedef short bf16x8 __attribute__((ext_vector_type(8)));
typedef float f32x16 __attribute__((ext_vector_type(16)));
typedef float f32x4 __attribute__((ext_vector_type(4)));
typedef unsigned u32x4 __attribute__((ext_vector_type(4)));
typedef short v4i16 __attribute__((ext_vector_type(4)));
#define ALDS __attribute__((address_space(3)))
constexpr int S = 4096, KSTR = 144, VSTR = 192, KBUF = 64 * KSTR, VBUF = 64 * VSTR;
constexpr int OFF_K = 0, OFF_V = 2 * KBUF, OFF_CK = OFF_V + 2 * VBUF, OFF_FLAG = OFF_CK + 512, OFF_WSF = OFF_FLAG + 64, OFF_BIAS = OFF_WSF + 8 * 64 * 4, LDS_END = OFF_BIAS + 512;
constexpr float LOG2E = 1.4426950408889634f;
enum { SB = 0, FOX = 1, SWA = 2 };
constexpr float RESCALE_THR = 8.0f;
constexpr float DEAD_LOG2 = 128.0f;
__device__ __forceinline__ int crow(int r, int hi) { return (r & 3) + 8 * (r >> 2) + 4 * hi; }
typedef float f32x2_t __attribute__((ext_vector_type(2))); typedef __bf16 bf16x2_t __attribute__((ext_vector_type(2)));
__device__ __forceinline__ unsigned pk(float lo, float hi) { f32x2_t v = {lo, hi}; bf16x2_t b = __builtin_convertvector(v, bf16x2_t); return __builtin_bit_cast(unsigned, b); }
__device__ __forceinline__ v4i16 vtr(const ALDS unsigned char* p) { return __builtin_amdgcn_ds_read_tr16_b64_v4i16((ALDS v4i16*)p); }
__device__ __forceinline__ bf16x8 pack8(const f32x16& p, int b) {
    u32x4 w; w.x = pk(p[b], p[b + 1]); w.y = pk(p[b + 2], p[b + 3]); w.z = pk(p[b + 4], p[b + 5]); w.w = pk(p[b + 6], p[b + 7]); return __builtin_bit_cast(bf16x8, w); }

struct AttnArgs { const bf16_t* Q; const bf16_t* K; const bf16_t* V; bf16_t* O; int kvp; const float* cl; const float* relb; const float* sinks; const unsigned* kmax2; unsigned* qctr; };

template <int MODE, bool MASK>
__device__ __forceinline__ void tile_qk(const ALDS unsigned char* kbuf, const ALDS float* ckb, const ALDS float* biastab, ALDS float* wsf,
                                        const bf16x8 (&qr)[4], f32x16& o0, f32x16& o1, float& m, float& l, float& carry, const float cq, const int kt, const int qrow,
                                        const int r32, const int hi, const int lane, const bf16x8 (&tf)[2], bf16x8 (&pa)[4]) {
    f32x16 p0, p1;
    const ALDS unsigned char* kb = kbuf + r32 * KSTR + hi * 16;
    const int kbase = kt * 64 + 4 * hi - qrow;
    if (MODE == SB) {
#pragma unroll
        for (int half = 1; half >= 0; --half) {
            const bf16x8 zero8 = (bf16x8){0, 0, 0, 0, 0, 0, 0, 0};
            if (MASK && half == 1 && (kt * 64 + 32 > __builtin_amdgcn_readfirstlane(qrow) + 31)) { pa[2] = zero8; pa[3] = zero8; continue; }
            if (half == 0 && __all(carry > DEAD_LOG2)) { pa[0] = zero8; pa[1] = zero8; break; }
            f32x16 p; bf16x8 kf4[4];
#pragma unroll
            for (int r = 0; r < 16; ++r) p[r] = 0.f;
#pragma unroll
            for (int dc = 0; dc < 4; ++dc) kf4[dc] = *(const ALDS bf16x8*)(kb + half * 32 * KSTR + dc * 32);
            __builtin_amdgcn_sched_barrier(0);
#pragma unroll
            for (int dc = 0; dc < 4; ++dc) p = __builtin_amdgcn_mfma_f32_32x32x16_bf16(kf4[dc], qr[dc], p, 0, 0, 0);
            f32x16 x;
#pragma unroll
            for (int r = 0; r < 16; ++r) { const int ko = (r & 3) + 8 * (r >> 2) + 32 * half;
                const float z = fminf(p[r], 126.f); float L = __builtin_amdgcn_logf(1.0f + __builtin_amdgcn_exp2f(z)); if (MASK) L = (kbase + ko < 0) ? L : 0.f; x[r] = L; p[r] = z - L; }
            u32x4 hh[2];
#pragma unroll
            for (int s = 0; s < 2; ++s)
#pragma unroll
                for (int i = 0; i < 4; ++i) hh[s][i] = pk(x[8 * s + 2 * i], x[8 * s + 2 * i + 1]);
            f32x16 y;
#pragma unroll
            for (int r = 0; r < 16; ++r) y[r] = carry;
            y = __builtin_amdgcn_mfma_f32_32x32x16_bf16(tf[0], __builtin_bit_cast(bf16x8, hh[0]), y, 0, 0, 0);
            y = __builtin_amdgcn_mfma_f32_32x32x16_bf16(tf[1], __builtin_bit_cast(bf16x8, hh[1]), y, 0, 0, 0);
            const float nc = y[0] + __uint_as_float(hh[0][0] << 16);
            carry = __shfl(nc, r32);
#pragma unroll
            for (int r = 0; r < 16; ++r) { const int ko = (r & 3) + 8 * (r >> 2) + 32 * half;
                float w = __builtin_amdgcn_exp2f(p[r] - y[r]); if (MASK) w = (kbase + ko < 0) ? w : 0.f; p[r] = w; }
            pa[2 * half] = pack8(p, 0); pa[2 * half + 1] = pack8(p, 8);
            __builtin_amdgcn_sched_barrier(0);
        }
    } else {
        const float NEG = -INFINITY;
        if (MODE == FOX) {
            const float cref = ckb[63];
            const float cin = MASK ? (cq - cref) : (cq - cref - m);
#pragma unroll
            for (int r = 0; r < 16; ++r) { p0[r] = cin; p1[r] = cin; }
            { const ALDS unsigned char* ka = kbuf + r32 * KSTR + 128;
              bf16x8 qa; qa[0] = hi ? (short)0 : (short)0x3F80; qa[1] = qa[0]; qa[2] = 0; qa[3] = 0; qa[4] = 0; qa[5] = 0; qa[6] = 0; qa[7] = 0;
              bf16x8 f0[5], f1[5];
#pragma unroll
              for (int dc = 0; dc < 4; ++dc) { f0[dc] = *(const ALDS bf16x8*)(kb + dc * 32); f1[dc] = *(const ALDS bf16x8*)(kb + 32 * KSTR + dc * 32); }
              f0[4] = *(const ALDS bf16x8*)ka; f1[4] = *(const ALDS bf16x8*)(ka + 32 * KSTR);
              __builtin_amdgcn_sched_barrier(0);
#pragma unroll
              for (int dc = 0; dc < 4; ++dc) { p0 = __builtin_amdgcn_mfma_f32_32x32x16_bf16(f0[dc], qr[dc], p0, 0, 0, 0); p1 = __builtin_amdgcn_mfma_f32_32x32x16_bf16(f1[dc], qr[dc], p1, 0, 0, 0); }
              p0 = __builtin_amdgcn_mfma_f32_32x32x16_bf16(f0[4], qa, p0, 0, 0, 0); p1 = __builtin_amdgcn_mfma_f32_32x32x16_bf16(f1[4], qa, p1, 0, 0, 0); }
            if (MASK) {
#pragma unroll
                for (int r = 0; r < 16; ++r) { const int ko = (r & 3) + 8 * (r >> 2); if (kbase + ko > 0) p0[r] = NEG; if (kbase + ko + 32 > 0) p1[r] = NEG; }
            }
            float mq[4];
#pragma unroll
            for (int r = 0; r < 4; ++r) mq[r] = fmaxf(p0[r], p1[r]);
#pragma unroll
            for (int r = 4; r < 16; ++r) mq[r & 3] = fmaxf(mq[r & 3], fmaxf(p0[r], p1[r]));
            float mx = fmaxf(fmaxf(mq[0], mq[1]), fmaxf(mq[2], mq[3]));
            { auto rr = __builtin_amdgcn_permlane32_swap(__float_as_uint(mx), __float_as_uint(mx), false, false); mx = fmaxf(__uint_as_float(rr[0]), __uint_as_float(rr[1])); }
            if (MASK) {
                m = mx;
#pragma unroll
                for (int r = 0; r < 16; ++r) { p0[r] -= mx; p1[r] -= mx; }
            } else if (__any(mx > RESCALE_THR)) {
                const float d = fmaxf(mx, 0.f); m += d; const float f = __builtin_amdgcn_exp2f(-d); l *= f;
                if (hi == 0) wsf[r32] = f;
#pragma unroll
                for (int r = 0; r < 16; ++r) { const float fr = wsf[crow(r, hi)]; o0[r] *= fr; o1[r] *= fr; p0[r] -= d; p1[r] -= d; }
            }
            float lq[4] = {0.f, 0.f, 0.f, 0.f};
#pragma unroll
            for (int r = 0; r < 16; ++r) { p0[r] = __builtin_amdgcn_exp2f(p0[r]); p1[r] = __builtin_amdgcn_exp2f(p1[r]); lq[r & 3] += p0[r] + p1[r]; }
            l += (lq[0] + lq[1]) + (lq[2] + lq[3]);
        } else {
#pragma unroll
            for (int r = 0; r < 16; ++r) { p0[r] = 0.f; p1[r] = 0.f; }
            { bf16x8 f0[4], f1[4];
#pragma unroll
              for (int dc = 0; dc < 4; ++dc) { f0[dc] = *(const ALDS bf16x8*)(kb + dc * 32); f1[dc] = *(const ALDS bf16x8*)(kb + 32 * KSTR + dc * 32); }
              __builtin_amdgcn_sched_barrier(0);
#pragma unroll
              for (int dc = 0; dc < 4; ++dc) { p0 = __builtin_amdgcn_mfma_f32_32x32x16_bf16(f0[dc], qr[dc], p0, 0, 0, 0); p1 = __builtin_amdgcn_mfma_f32_32x32x16_bf16(f1[dc], qr[dc], p1, 0, 0, 0); } }
#pragma unroll
            for (int r = 0; r < 16; ++r) { const int ko = (r & 3) + 8 * (r >> 2);
                { const int dist = -(kbase + ko); const bool ok = (unsigned)dist < 128u; const float bv = biastab[dist & 127]; p0[r] = ok ? p0[r] + bv : NEG; }
                { const int dist = -(kbase + ko + 32); const bool ok = (unsigned)dist < 128u; const float bv = biastab[dist & 127]; p1[r] = ok ? p1[r] + bv : NEG; } }
            float mq[4];
#pragma unroll
            for (int r = 0; r < 4; ++r) mq[r] = fmaxf(p0[r], p1[r]);
#pragma unroll
            for (int r = 4; r < 16; ++r) mq[r & 3] = fmaxf(mq[r & 3], fmaxf(p0[r], p1[r]));
            float mx = fmaxf(fmaxf(mq[0], mq[1]), fmaxf(mq[2], mq[3]));
            { auto rr = __builtin_amdgcn_permlane32_swap(__float_as_uint(mx), __float_as_uint(mx), false, false); mx = fmaxf(__uint_as_float(rr[0]), __uint_as_float(rr[1])); }
            if (__any(mx > m + RESCALE_THR)) {
                const float mnew = fmaxf(m, mx); const float f = __builtin_amdgcn_exp2f(m - mnew); l *= f; m = mnew;
                if (hi == 0) wsf[r32] = f;
#pragma unroll
                for (int r = 0; r < 16; ++r) { const float fr = wsf[crow(r, hi)]; o0[r] *= fr; o1[r] *= fr; }
            }
            float lq[4] = {0.f, 0.f, 0.f, 0.f};
#pragma unroll
            for (int r = 0; r < 16; ++r) { p0[r] = __builtin_amdgcn_exp2f(p0[r] - m); p1[r] = __builtin_amdgcn_exp2f(p1[r] - m); lq[r & 3] += p0[r] + p1[r]; }
            l += (lq[0] + lq[1]) + (lq[2] + lq[3]);
        }
    }
    if (MODE != SB) { pa[0] = pack8(p0, 0); pa[1] = pack8(p0, 8); pa[2] = pack8(p1, 0); pa[3] = pack8(p1, 8); }
}
__device__ __forceinline__ void tile_pv(const ALDS unsigned char* vbuf, const bf16x8 (&pa)[4], f32x16& o0, f32x16& o1, const int hi, const int lane) {
    const ALDS unsigned char* vb = vbuf + (4 * hi + ((lane & 15) >> 2)) * VSTR + ((lane >> 4) & 1) * 32 + (lane & 3) * 8;
    v4i16 va[4], vb_[4], vc[4], vd[4];
#pragma unroll
    for (int s = 0; s < 4; ++s) { va[s] = vtr(vb + s * 16 * VSTR); vb_[s] = vtr(vb + s * 16 * VSTR + 8 * VSTR); vc[s] = vtr(vb + s * 16 * VSTR + 64); vd[s] = vtr(vb + s * 16 * VSTR + 8 * VSTR + 64); }
    __builtin_amdgcn_sched_barrier(0);
#pragma unroll
    for (int s = 0; s < 4; ++s) {
        const bf16x8 v0 = (bf16x8){va[s][0], va[s][1], va[s][2], va[s][3], vb_[s][0], vb_[s][1], vb_[s][2], vb_[s][3]}, v1 = (bf16x8){vc[s][0], vc[s][1], vc[s][2], vc[s][3], vd[s][0], vd[s][1], vd[s][2], vd[s][3]};
        o0 = __builtin_amdgcn_mfma_f32_32x32x16_bf16(pa[s], v0, o0, 0, 0, 0);
        o1 = __builtin_amdgcn_mfma_f32_32x32x16_bf16(pa[s], v1, o1, 0, 0, 0);
    }
}


__device__ __forceinline__ void sb_tile_pipelined(const ALDS unsigned char* kbuf, const ALDS unsigned char* vbuf, const bf16x8 (&qr)[4], f32x16& o0, f32x16& o1, float& carry,
                                                  const int r32, const int hi, const int lane, const bf16x8 (&tf)[2]) {
    const ALDS unsigned char* kb = kbuf + r32 * KSTR + hi * 16;
    bf16x8 k1[4], k0[4];
#pragma unroll
    for (int dc = 0; dc < 4; ++dc) { k1[dc] = *(const ALDS bf16x8*)(kb + 32 * KSTR + dc * 32); k0[dc] = *(const ALDS bf16x8*)(kb + dc * 32); }
    __builtin_amdgcn_sched_barrier(0);
    f32x16 p1, p0;
#pragma unroll
    for (int r = 0; r < 16; ++r) { p1[r] = 0.f; p0[r] = 0.f; }
#pragma unroll
    for (int dc = 0; dc < 4; ++dc) p1 = __builtin_amdgcn_mfma_f32_32x32x16_bf16(k1[dc], qr[dc], p1, 0, 0, 0);
#pragma unroll
    for (int dc = 0; dc < 4; ++dc) p0 = __builtin_amdgcn_mfma_f32_32x32x16_bf16(k0[dc], qr[dc], p0, 0, 0, 0);
    __builtin_amdgcn_sched_barrier(0);
    u32x4 h1[2], h0[2];
    { f32x16 x;
#pragma unroll
      for (int r = 0; r < 16; ++r) { const float z = fminf(p1[r], 126.f); const float L = __builtin_amdgcn_logf(1.0f + __builtin_amdgcn_exp2f(z)); x[r] = L; p1[r] = z - L; }
#pragma unroll
      for (int s = 0; s < 2; ++s)
#pragma unroll
          for (int i = 0; i < 4; ++i) h1[s][i] = pk(x[8 * s + 2 * i], x[8 * s + 2 * i + 1]); }
    f32x16 y1;
#pragma unroll
    for (int r = 0; r < 16; ++r) y1[r] = carry;
    y1 = __builtin_amdgcn_mfma_f32_32x32x16_bf16(tf[0], __builtin_bit_cast(bf16x8, h1[0]), y1, 0, 0, 0);
    y1 = __builtin_amdgcn_mfma_f32_32x32x16_bf16(tf[1], __builtin_bit_cast(bf16x8, h1[1]), y1, 0, 0, 0);
    __builtin_amdgcn_sched_barrier(0);
    { f32x16 x;
#pragma unroll
      for (int r = 0; r < 16; ++r) { const float z = fminf(p0[r], 126.f); const float L = __builtin_amdgcn_logf(1.0f + __builtin_amdgcn_exp2f(z)); x[r] = L; p0[r] = z - L; }
#pragma unroll
      for (int s = 0; s < 2; ++s)
#pragma unroll
          for (int i = 0; i < 4; ++i) h0[s][i] = pk(x[8 * s + 2 * i], x[8 * s + 2 * i + 1]); }
    __builtin_amdgcn_sched_barrier(0);
    { const float nc = y1[0] + __uint_as_float(h1[0][0] << 16); carry = __shfl(nc, r32); }
    f32x16 y0;
#pragma unroll
    for (int r = 0; r < 16; ++r) y0[r] = carry;
    y0 = __builtin_amdgcn_mfma_f32_32x32x16_bf16(tf[0], __builtin_bit_cast(bf16x8, h0[0]), y0, 0, 0, 0);
    y0 = __builtin_amdgcn_mfma_f32_32x32x16_bf16(tf[1], __builtin_bit_cast(bf16x8, h0[1]), y0, 0, 0, 0);
    const ALDS unsigned char* vb = vbuf + (4 * hi + ((lane & 15) >> 2)) * VSTR + ((lane >> 4) & 1) * 32 + (lane & 3) * 8;
    v4i16 va[2], vb_[2], vc[2], vd[2];
#pragma unroll
    for (int s = 0; s < 2; ++s) { va[s] = vtr(vb + (s + 2) * 16 * VSTR); vb_[s] = vtr(vb + (s + 2) * 16 * VSTR + 8 * VSTR); vc[s] = vtr(vb + (s + 2) * 16 * VSTR + 64); vd[s] = vtr(vb + (s + 2) * 16 * VSTR + 8 * VSTR + 64); }
    __builtin_amdgcn_sched_barrier(0);
    bf16x8 pa2, pa3;
#pragma unroll
    for (int r = 0; r < 16; ++r) p1[r] = __builtin_amdgcn_exp2f(p1[r] - y1[r]);
    pa2 = pack8(p1, 0); pa3 = pack8(p1, 8);
    __builtin_amdgcn_sched_barrier(0);
#pragma unroll
    for (int s = 0; s < 2; ++s) {
        const bf16x8 v0 = (bf16x8){va[s][0], va[s][1], va[s][2], va[s][3], vb_[s][0], vb_[s][1], vb_[s][2], vb_[s][3]}, v1 = (bf16x8){vc[s][0], vc[s][1], vc[s][2], vc[s][3], vd[s][0], vd[s][1], vd[s][2], vd[s][3]};
        o0 = __builtin_amdgcn_mfma_f32_32x32x16_bf16(s ? pa3 : pa2, v0, o0, 0, 0, 0);
        o1 = __builtin_amdgcn_mfma_f32_32x32x16_bf16(s ? pa3 : pa2, v1, o1, 0, 0, 0);
    }
#pragma unroll
    for (int s = 0; s < 2; ++s) { va[s] = vtr(vb + s * 16 * VSTR); vb_[s] = vtr(vb + s * 16 * VSTR + 8 * VSTR); vc[s] = vtr(vb + s * 16 * VSTR + 64); vd[s] = vtr(vb + s * 16 * VSTR + 8 * VSTR + 64); }
    __builtin_amdgcn_sched_barrier(0);
    const bool dead = __all(carry > DEAD_LOG2);
    { const float nc = y0[0] + __uint_as_float(h0[0][0] << 16); carry = __shfl(nc, r32); }
    if (!dead) {
#pragma unroll
        for (int r = 0; r < 16; ++r) p0[r] = __builtin_amdgcn_exp2f(p0[r] - y0[r]);
        const bf16x8 pa0 = pack8(p0, 0), pa1 = pack8(p0, 8);
#pragma unroll
        for (int s = 0; s < 2; ++s) {
            const bf16x8 v0 = (bf16x8){va[s][0], va[s][1], va[s][2], va[s][3], vb_[s][0], vb_[s][1], vb_[s][2], vb_[s][3]}, v1 = (bf16x8){vc[s][0], vc[s][1], vc[s][2], vc[s][3], vd[s][0], vd[s][1], vd[s][2], vd[s][3]};
            o0 = __builtin_amdgcn_mfma_f32_32x32x16_bf16(s ? pa1 : pa0, v0, o0, 0, 0, 0);
            o1 = __builtin_amdgcn_mfma_f32_32x32x16_bf16(s ? pa1 : pa0, v1, o1, 0, 0, 0);
        }
    }
}
template <int MODE, bool MASK>
__device__ __forceinline__ void tile(const ALDS unsigned char* kbuf, const ALDS unsigned char* vbuf, const ALDS float* ckb, const ALDS float* biastab, ALDS float* wsf,
                                     const bf16x8 (&qr)[4], f32x16& o0, f32x16& o1, float& m, float& l, float& carry, const float cq, const int kt, const int qrow,
                                     const int r32, const int hi, const int lane, const bf16x8 (&tf)[2], const bf16x8 ones) {
    if (MODE == SB && !MASK) { sb_tile_pipelined(kbuf, vbuf, qr, o0, o1, carry, r32, hi, lane, tf); return; }
    bf16x8 pa[4];
    tile_qk<MODE, MASK>(kbuf, ckb, biastab, wsf, qr, o0, o1, m, l, carry, cq, kt, qrow, r32, hi, lane, tf, pa);
    tile_pv(vbuf, pa, o0, o1, hi, lane);
}
template <int MODE>
__device__ __forceinline__ void attn_unit(ALDS unsigned char* lds, const AttnArgs& A, const int b, const int h, const int qblk) {
    const int tid = tid_opaque(), lane = tid & 63, r32 = lane & 31, hi = lane >> 5; const int wid = __builtin_amdgcn_readfirstlane(tid >> 6);
    const int q0 = qblk * 256, R = q0 + 32 * wid, qrow = R + r32;
    const size_t rowbase = (size_t)b * S; const int kvp = A.kvp;
    const int kvh = (MODE == SWA) ? (h >> 2) : h;
    const int kt_hi = (q0 >> 6) + 3; int kt_lo = 0; if (MODE == SWA) { kt_lo = (q0 - 128) >> 6; if (kt_lo < 0) kt_lo = 0; }
    const int n = kt_hi - kt_lo + 1;
    const int srow = tid >> 3, sch = tid & 7;
    const bf16_t* ksrc = A.K + (rowbase + srow) * kvp + kvh * 64 + sch * 8;
    const bf16_t* vsrc = A.V + (rowbase + srow) * kvp + kvh * 64 + sch * 8;
    const float* clh = A.cl + (size_t)(b * 16 + h) * S;
    ALDS unsigned char* kdst = lds + OFF_K + srow * KSTR + sch * 16; ALDS unsigned char* vdst = lds + OFF_V + srow * VSTR + sch * 16;
    ALDS float* ckl = (ALDS float*)(lds + OFF_CK); ALDS unsigned* flags = (ALDS unsigned*)(lds + OFF_FLAG);
    ALDS float* wsf = (ALDS float*)(lds + OFF_WSF) + wid * 64; ALDS float* biastab = (ALDS float*)(lds + OFF_BIAS);
    bf16x8 qr[4];
#pragma unroll
    for (int dc = 0; dc < 4; ++dc) qr[dc] = *(const bf16x8*)(A.Q + (rowbase + qrow) * 1024 + h * 64 + dc * 16 + hi * 8);
    if (MODE == SWA) { if (tid < 128) { int bk = tid; if (tid >= 16) { bk = 16 + (int)(logf((float)tid / 16.0f) / logf(8.0f) * 16.0f); if (bk > 31) bk = 31; } biastab[tid] = A.relb[bk * 16 + h] * LOG2E; } }
    f32x16 o0, o1;
#pragma unroll
    for (int r = 0; r < 16; ++r) { o0[r] = 0.f; o1[r] = 0.f; }
    float m = -INFINITY, l = 0.f, carry = 0.f; float cq = 0.f; if (MODE == FOX) cq = clh[qrow];
    bf16x8 tf[2], ones;
#pragma unroll
    for (int j = 0; j < 8; ++j) { ones[j] = (short)0x3F80;
#pragma unroll
        for (int s = 0; s < 2; ++s) { const int jk = 16 * s + 8 * (j >> 2) + 4 * hi + (j & 3); tf[s][j] = (jk > r32) ? (short)0x3F80 : (short)0; } }
    u32x4 kreg, vreg; float ckreg = 0.f, crreg = 0.f;
#define FOX_PAD(d_) ({ const float dh_ = __uint_as_float(pk((d_), 0.f) << 16); (u32x4){pk(-dh_, -((d_) - dh_)), 0u, 0u, 0u}; })
    { const size_t go = (size_t)kt_hi * 64 * kvp; kreg = *(const u32x4*)(ksrc + go); vreg = *(const u32x4*)(vsrc + go); if (MODE == FOX && tid < 64) { ckreg = clh[kt_hi * 64 + tid]; crreg = clh[kt_hi * 64 + 63]; } }
    *(ALDS u32x4*)kdst = kreg; *(ALDS u32x4*)vdst = vreg; if (MODE == FOX && tid < 64) { ckl[tid] = ckreg; *(ALDS u32x4*)(lds + OFF_K + tid * KSTR + 128) = FOX_PAD(ckreg - crreg); }
    __syncthreads();
    bool wdone = false;
    for (int it = 0; it < n; ++it) {
        const int kt = kt_hi - it, buf = it & 1;
        if (it + 1 < n) { const size_t go = (size_t)(kt - 1) * 64 * kvp; kreg = *(const u32x4*)(ksrc + go); vreg = *(const u32x4*)(vsrc + go); if (MODE == FOX && tid < 64) { ckreg = clh[(kt - 1) * 64 + tid]; crreg = clh[(kt - 1) * 64 + 63]; } }
        bool active = (kt * 64 <= R + 31) && !wdone;
        if (MODE == SWA) active = active && (kt * 64 + 63 >= R - 127);
        if (active) {
            const ALDS unsigned char* kbuf = lds + OFF_K + buf * KBUF; const ALDS unsigned char* vbuf = lds + OFF_V + buf * VBUF; const ALDS float* ckb = ckl + buf * 64;
            if (MODE == SWA || kt * 64 + 63 >= R) tile<MODE, true>(kbuf, vbuf, ckb, biastab, wsf, qr, o0, o1, m, l, carry, cq, kt, qrow, r32, hi, lane, tf, ones);
            else tile<MODE, false>(kbuf, vbuf, ckb, biastab, wsf, qr, o0, o1, m, l, carry, cq, kt, qrow, r32, hi, lane, tf, ones);
            if (MODE == SB) wdone = __all(carry > DEAD_LOG2);
        }
        if (MODE == SB) { if (lane == 0) flags[buf * 8 + wid] = wdone ? 1u : 0u; }
        if (it + 1 < n) { *(ALDS u32x4*)(kdst + (buf ^ 1) * KBUF) = kreg; *(ALDS u32x4*)(vdst + (buf ^ 1) * VBUF) = vreg; if (MODE == FOX && tid < 64) { ckl[(buf ^ 1) * 64 + tid] = ckreg; *(ALDS u32x4*)(lds + OFF_K + (buf ^ 1) * KBUF + tid * KSTR + 128) = FOX_PAD(ckreg - crreg); } }
        __syncthreads();
        if (MODE == SB) { unsigned all = 1u;
#pragma unroll
            for (int w = 0; w < 8; ++w) all &= flags[buf * 8 + w];
            if (all) break; }
    }
    float fr[16];
    if (MODE == SB) {
#pragma unroll
        for (int r = 0; r < 16; ++r) fr[r] = 1.f;
    } else {
        float lt = l + __shfl_xor(l, 32);
        if (MODE == SWA) lt += __builtin_amdgcn_exp2f(A.sinks[h] * LOG2E - m);
        const float rl = 1.0f / lt;
        if (hi == 0) wsf[r32] = rl;
#pragma unroll
        for (int r = 0; r < 16; ++r) fr[r] = wsf[crow(r, hi)];
    }
    __hip_bfloat16* Ob = (__hip_bfloat16*)A.O + (rowbase + R) * 1024 + h * 64 + r32;
#pragma unroll
    for (int r = 0; r < 16; ++r) { const int row = crow(r, hi); Ob[(size_t)row * 1024] = __float2bfloat16(o0[r] * fr[r]); Ob[(size_t)row * 1024 + 32] = __float2bfloat16(o1[r] * fr[r]); }
}

constexpr int NSLOT = 5, R_OFF_K = 0, R_OFF_V = NSLOT * KBUF, R_OFF_FLAG = R_OFF_V + NSLOT * VBUF, R_OFF_WSF = R_OFF_FLAG + 64, R_OFF_BIAS = R_OFF_WSF + 8 * 64 * 4, R_LDS_END = R_OFF_BIAS + 512;
static_assert(R_LDS_END <= 131072, "ring fits the phase scratch");
template <int MODE>
__device__ __forceinline__ void attn_unit_ring(ALDS unsigned char* lds, const AttnArgs& A, const int b, const int h, const int qblk) {
    const int tid = tid_opaque(), lane = tid & 63, r32 = lane & 31, hi = lane >> 5; const int wid = __builtin_amdgcn_readfirstlane(tid >> 6);
    const int q0 = qblk * 256, R = q0 + 32 * wid, qrow = R + r32;
    const size_t rowbase = (size_t)b * S; const int kvp = A.kvp;
    const int kvh = (MODE == SWA) ? (h >> 2) : h;
    const int kt_hi = (q0 >> 6) + 3; const int diag = kt_hi - 3 + (wid >> 1);
    const int srow = tid >> 3, sch = tid & 7;
    const bf16_t* ksrc = A.K + (rowbase + srow) * kvp + kvh * 64 + sch * 8;
    const bf16_t* vsrc = A.V + (rowbase + srow) * kvp + kvh * 64 + sch * 8;
    ALDS unsigned char* kdst = lds + R_OFF_K + srow * KSTR + sch * 16; ALDS unsigned char* vdst = lds + R_OFF_V + srow * VSTR + sch * 16;
    ALDS unsigned* flags = (ALDS unsigned*)(lds + R_OFF_FLAG);
    ALDS float* wsf = (ALDS float*)(lds + R_OFF_WSF) + wid * 64; ALDS float* biastab = (ALDS float*)(lds + R_OFF_BIAS);
    bf16x8 qr[4];
#pragma unroll
    for (int dc = 0; dc < 4; ++dc) qr[dc] = *(const bf16x8*)(A.Q + (rowbase + qrow) * 1024 + h * 64 + dc * 16 + hi * 8);
    if (MODE == SWA) { if (tid < 128) { int bk = tid; if (tid >= 16) { bk = 16 + (int)(logf((float)tid / 16.0f) / logf(8.0f) * 16.0f); if (bk > 31) bk = 31; } biastab[tid] = A.relb[bk * 16 + h] * LOG2E; } }
    f32x16 o0, o1;
#pragma unroll
    for (int r = 0; r < 16; ++r) { o0[r] = 0.f; o1[r] = 0.f; }
    float m = -INFINITY, l = 0.f, carry = 0.f;
    bf16x8 tf[2], ones;
#pragma unroll
    for (int j = 0; j < 8; ++j) { ones[j] = (short)0x3F80;
#pragma unroll
        for (int s = 0; s < 2; ++s) { const int jk = 16 * s + 8 * (j >> 2) + 4 * hi + (j & 3); tf[s][j] = (jk > r32) ? (short)0x3F80 : (short)0; } }
    { u32x4 kp[4], vp[4];
#pragma unroll
      for (int tt = 0; tt < 4; ++tt) { const size_t go = (size_t)(kt_hi - tt) * 64 * kvp; kp[tt] = *(const u32x4*)(ksrc + go); vp[tt] = *(const u32x4*)(vsrc + go); }
      __builtin_amdgcn_sched_barrier(0);
#pragma unroll
      for (int tt = 0; tt < 4; ++tt) { const int sl = (kt_hi - tt) % NSLOT; *(ALDS u32x4*)(kdst + sl * KBUF) = kp[tt]; *(ALDS u32x4*)(vdst + sl * VBUF) = vp[tt]; } }
    __syncthreads();
    bool wdone = false;
    for (int j = 0;; ++j) {
        const int tp = kt_hi - 4 - j; u32x4 kreg, vreg;
        if (tp >= 0) { const size_t go = (size_t)tp * 64 * kvp; kreg = *(const u32x4*)(ksrc + go); vreg = *(const u32x4*)(vsrc + go); }
        const int kt = diag - j;
        bool active = (kt >= 0) && !wdone;
        if (MODE == SWA) active = active && (kt * 64 + 63 >= R - 127);
        if (active) {
            const int sl = kt % NSLOT;
            const ALDS unsigned char* kbuf = lds + R_OFF_K + sl * KBUF; const ALDS unsigned char* vbuf = lds + R_OFF_V + sl * VBUF;
            if (MODE == SWA || j == 0) tile<MODE, true>(kbuf, vbuf, (const ALDS float*)nullptr, biastab, wsf, qr, o0, o1, m, l, carry, 0.f, kt, qrow, r32, hi, lane, tf, ones);
            else tile<MODE, false>(kbuf, vbuf, (const ALDS float*)nullptr, biastab, wsf, qr, o0, o1, m, l, carry, 0.f, kt, qrow, r32, hi, lane, tf, ones);
            if (MODE == SB) wdone = __all(carry > DEAD_LOG2);
        }
        bool fin = wdone || (kt - 1 < 0);
        if (MODE == SWA) fin = fin || ((kt - 1) * 64 + 63 < R - 127);
        if (lane == 0) flags[(j & 1) * 8 + wid] = fin ? 1u : 0u;
        if (tp >= 0) { const int sl = tp % NSLOT; *(ALDS u32x4*)(kdst + sl * KBUF) = kreg; *(ALDS u32x4*)(vdst + sl * VBUF) = vreg; }
        __syncthreads();
        unsigned all = 1u;
#pragma unroll
        for (int w = 0; w < 8; ++w) all &= flags[(j & 1) * 8 + w];
        if (all) break;
    }
    float fr[16];
    if (MODE == SB) {
#pragma unroll
        for (int r = 0; r < 16; ++r) fr[r] = 1.f;
    } else {
        float lt = l + __shfl_xor(l, 32);
        if (MODE == SWA) lt += __builtin_amdgcn_exp2f(A.sinks[h] * LOG2E - m);
        const float rl = 1.0f / lt;
        if (hi == 0) wsf[r32] = rl;
#pragma unroll
        for (int r = 0; r < 16; ++r) fr[r] = wsf[crow(r, hi)];
    }
    __hip_bfloat16* Ob = (__hip_bfloat16*)A.O + (rowbase + R) * 1024 + h * 64 + r32;
#pragma unroll
    for (int r = 0; r < 16; ++r) { const int row = crow(r, hi); Ob[(size_t)row * 1024] = __float2bfloat16(o0[r] * fr[r]); Ob[(size_t)row * 1024 + 32] = __float2bfloat16(o1[r] * fr[r]); }
}

constexpr int F_OFF_K = 0, F_OFF_V = 4 * KBUF, F_OFF_CK = F_OFF_V + 4 * VBUF, F_OFF_WSF = F_OFF_CK + 1024, F_OFF_FLAG = F_OFF_WSF + 8 * 64 * 4, F_LDS_END = F_OFF_FLAG + 64;
static_assert(F_LDS_END <= 131072, "FoX stage buffers fit the phase scratch");
__device__ __forceinline__ void fox_pair_fast(const ALDS unsigned char* kbufA, const ALDS unsigned char* kbufB, const ALDS unsigned char* vbufA, const ALDS unsigned char* vbufB,
                                              const ALDS float* ckbA, const ALDS float* ckbB, ALDS float* wsf, const bf16x8 (&qr)[4], f32x16& o0, f32x16& o1, float& m, float& l,
                                              const float cq, const int r32, const int hi, const int lane) {
    const float base = cq - m, cinA = base - ckbA[63], cinB = base - ckbB[63];
    f32x16 a0, a1, b0, b1;
#pragma unroll
    for (int r = 0; r < 16; ++r) { a0[r] = cinA; a1[r] = cinA; b0[r] = cinB; b1[r] = cinB; }
    const ALDS unsigned char* ka = kbufA + r32 * KSTR + hi * 16; const ALDS unsigned char* kb = kbufB + r32 * KSTR + hi * 16;
    { bf16x8 qa; qa[0] = hi ? (short)0 : (short)0x3F80; qa[1] = qa[0]; qa[2] = 0; qa[3] = 0; qa[4] = 0; qa[5] = 0; qa[6] = 0; qa[7] = 0;
      const ALDS unsigned char* pa_ = kbufA + r32 * KSTR + 128; const ALDS unsigned char* pb_ = kbufB + r32 * KSTR + 128;
      bf16x8 fa0[5], fa1[5], fb0[5], fb1[5];
#pragma unroll
      for (int dc = 0; dc < 4; ++dc) { fa0[dc] = *(const ALDS bf16x8*)(ka + dc * 32); fa1[dc] = *(const ALDS bf16x8*)(ka + 32 * KSTR + dc * 32); }
      fa0[4] = *(const ALDS bf16x8*)pa_; fa1[4] = *(const ALDS bf16x8*)(pa_ + 32 * KSTR);
#pragma unroll
      for (int dc = 0; dc < 4; ++dc) { fb0[dc] = *(const ALDS bf16x8*)(kb + dc * 32); fb1[dc] = *(const ALDS bf16x8*)(kb + 32 * KSTR + dc * 32); }
      fb0[4] = *(const ALDS bf16x8*)pb_; fb1[4] = *(const ALDS bf16x8*)(pb_ + 32 * KSTR);
      __builtin_amdgcn_sched_barrier(0);
#pragma unroll
      for (int dc = 0; dc < 4; ++dc) { a0 = __builtin_amdgcn_mfma_f32_32x32x16_bf16(fa0[dc], qr[dc], a0, 0, 0, 0); a1 = __builtin_amdgcn_mfma_f32_32x32x16_bf16(fa1[dc], qr[dc], a1, 0, 0, 0); }
      a0 = __builtin_amdgcn_mfma_f32_32x32x16_bf16(fa0[4], qa, a0, 0, 0, 0); a1 = __builtin_amdgcn_mfma_f32_32x32x16_bf16(fa1[4], qa, a1, 0, 0, 0);
#pragma unroll
      for (int dc = 0; dc < 4; ++dc) { b0 = __builtin_amdgcn_mfma_f32_32x32x16_bf16(fb0[dc], qr[dc], b0, 0, 0, 0); b1 = __builtin_amdgcn_mfma_f32_32x32x16_bf16(fb1[dc], qr[dc], b1, 0, 0, 0); }
      b0 = __builtin_amdgcn_mfma_f32_32x32x16_bf16(fb0[4], qa, b0, 0, 0, 0); b1 = __builtin_amdgcn_mfma_f32_32x32x16_bf16(fb1[4], qa, b1, 0, 0, 0); }
    float mq[4];
#pragma unroll
    for (int r = 0; r < 4; ++r) mq[r] = fmaxf(fmaxf(a0[r], a1[r]), fmaxf(b0[r], b1[r]));
#pragma unroll
    for (int r = 4; r < 16; ++r) mq[r & 3] = fmaxf(mq[r & 3], fmaxf(fmaxf(a0[r], a1[r]), fmaxf(b0[r], b1[r])));
    float mx = fmaxf(fmaxf(mq[0], mq[1]), fmaxf(mq[2], mq[3]));
    { auto rr = __builtin_amdgcn_permlane32_swap(__float_as_uint(mx), __float_as_uint(mx), false, false); mx = fmaxf(__uint_as_float(rr[0]), __uint_as_float(rr[1])); }
    if (__any(mx > RESCALE_THR)) {
        const float d = fmaxf(mx, 0.f); m += d; const float f = __builtin_amdgcn_exp2f(-d); l *= f;
        if (hi == 0) wsf[r32] = f;
#pragma unroll
        for (int r = 0; r < 16; ++r) { const float fr = wsf[crow(r, hi)]; o0[r] *= fr; o1[r] *= fr; a0[r] -= d; a1[r] -= d; b0[r] -= d; b1[r] -= d; }
    }
    float lq[4] = {0.f, 0.f, 0.f, 0.f};
#pragma unroll
    for (int r = 0; r < 16; ++r) { a0[r] = __builtin_amdgcn_exp2f(a0[r]); a1[r] = __builtin_amdgcn_exp2f(a1[r]); b0[r] = __builtin_amdgcn_exp2f(b0[r]); b1[r] = __builtin_amdgcn_exp2f(b1[r]); lq[r & 3] += (a0[r] + a1[r]) + (b0[r] + b1[r]); }
    l += (lq[0] + lq[1]) + (lq[2] + lq[3]);
    bf16x8 pA[4], pB[4];
    pA[0] = pack8(a0, 0); pA[1] = pack8(a0, 8); pA[2] = pack8(a1, 0); pA[3] = pack8(a1, 8);
    pB[0] = pack8(b0, 0); pB[1] = pack8(b0, 8); pB[2] = pack8(b1, 0); pB[3] = pack8(b1, 8);
    tile_pv(vbufA, pA, o0, o1, hi, lane);
    tile_pv(vbufB, pB, o0, o1, hi, lane);
}
__device__ __forceinline__ void attn_unit_fox(ALDS unsigned char* lds, const AttnArgs& A, const int b, const int h, const int qblk) {
    const int tid = tid_opaque(), lane = tid & 63, r32 = lane & 31, hi = lane >> 5; const int wid = __builtin_amdgcn_readfirstlane(tid >> 6);
    const int q0 = qblk * 256, R = q0 + 32 * wid, qrow = R + r32;
    const size_t rowbase = (size_t)b * S; const int kvp = A.kvp;
    const int kt_hi = (q0 >> 6) + 3, npairs = (kt_hi + 1) >> 1;
    const int srow = tid >> 3, sch = tid & 7;
    const bf16_t* ksrc = A.K + (rowbase + srow) * kvp + h * 64 + sch * 8;
    const bf16_t* vsrc = A.V + (rowbase + srow) * kvp + h * 64 + sch * 8;
    const float* clh = A.cl + (size_t)(b * 16 + h) * S;
    ALDS unsigned char* kdst = lds + F_OFF_K + srow * KSTR + sch * 16; ALDS unsigned char* vdst = lds + F_OFF_V + srow * VSTR + sch * 16;
    ALDS float* ckl = (ALDS float*)(lds + F_OFF_CK); ALDS float* wsf = (ALDS float*)(lds + F_OFF_WSF) + wid * 64;
    bf16x8 qr[4];
#pragma unroll
    for (int dc = 0; dc < 4; ++dc) qr[dc] = *(const bf16x8*)(A.Q + (rowbase + qrow) * 1024 + h * 64 + dc * 16 + hi * 8);
    f32x16 o0, o1;
#pragma unroll
    for (int r = 0; r < 16; ++r) { o0[r] = 0.f; o1[r] = 0.f; }
    float m = -INFINITY, l = 0.f, carry = 0.f; const float cq = clh[qrow];
    bf16x8 tf[2] = {}, ones = {};
    float qn2 = 0.f;
#pragma unroll
    for (int dc = 0; dc < 4; ++dc)
#pragma unroll
        for (int e = 0; e < 8; ++e) { const float qv = __uint_as_float(((unsigned)(unsigned short)qr[dc][e]) << 16); qn2 += qv * qv; }
    qn2 += __shfl_xor(qn2, 32);
    const float sbound = sqrtf(qn2) * sqrtf(__uint_as_float(A.kmax2[b * 16 + h])) * 1.01f + 1.0f;
    ALDS unsigned* flags = (ALDS unsigned*)(lds + F_OFF_FLAG);
    bool wdone = false;
    u32x4 kA, vA, kB, vB; float ckA = 0.f, crA = 0.f, ckB = 0.f, crB = 0.f;
#define FX_LOAD(j_) do { const int tA_ = kt_hi - 2 * (j_); const size_t gA_ = (size_t)tA_ * 64 * kvp, gB_ = (size_t)(tA_ - 1) * 64 * kvp; \
        kA = *(const u32x4*)(ksrc + gA_); vA = *(const u32x4*)(vsrc + gA_); kB = *(const u32x4*)(ksrc + gB_); vB = *(const u32x4*)(vsrc + gB_); \
        if (tid < 64) { ckA = clh[tA_ * 64 + tid]; crA = clh[tA_ * 64 + 63]; ckB = clh[(tA_ - 1) * 64 + tid]; crB = clh[(tA_ - 1) * 64 + 63]; } } while (0)
#define FX_WRITE(pb_) do { const int sA_ = 2 * (pb_), sB_ = sA_ + 1; \
        *(ALDS u32x4*)(kdst + sA_ * KBUF) = kA; *(ALDS u32x4*)(vdst + sA_ * VBUF) = vA; *(ALDS u32x4*)(kdst + sB_ * KBUF) = kB; *(ALDS u32x4*)(vdst + sB_ * VBUF) = vB; \
        if (tid < 64) { ckl[sA_ * 64 + tid] = ckA; ckl[sB_ * 64 + tid] = ckB; \
            *(ALDS u32x4*)(lds + F_OFF_K + sA_ * KBUF + tid * KSTR + 128) = FOX_PAD(ckA - crA); *(ALDS u32x4*)(lds + F_OFF_K + sB_ * KBUF + tid * KSTR + 128) = FOX_PAD(ckB - crB); } } while (0)
    FX_LOAD(0); FX_WRITE(0);
    __syncthreads();
    for (int j = 0; j < npairs; ++j) {
        const int pb = j & 1, tA = kt_hi - 2 * j, tB = tA - 1;
        if (j + 1 < npairs) FX_LOAD(j + 1);
        const ALDS unsigned char* kbA = lds + F_OFF_K + (2 * pb) * KBUF; const ALDS unsigned char* kbB = kbA + KBUF;
        const ALDS unsigned char* vbA = lds + F_OFF_V + (2 * pb) * VBUF; const ALDS unsigned char* vbB = vbA + VBUF;
        const ALDS float* ckbA = ckl + (2 * pb) * 64; const ALDS float* ckbB = ckbA + 64;
        const bool actA = (tA * 64 <= R + 31) && !wdone, actB = (tB * 64 <= R + 31) && !wdone;
        if (actA && (tA * 64 + 63 < R) && __all(sbound + (cq - ckbA[63] - m) < -DEAD_LOG2)) wdone = true;
        else if (actA && (tA * 64 + 63 < R) && __all(sbound + (cq - ckbB[63] - m) < -DEAD_LOG2)) {
            tile<FOX, false>(kbA, vbA, ckbA, (const ALDS float*)nullptr, wsf, qr, o0, o1, m, l, carry, cq, tA, qrow, r32, hi, lane, tf, ones); wdone = true; }
        else if (actA && (tA * 64 + 63 < R)) fox_pair_fast(kbA, kbB, vbA, vbB, ckbA, ckbB, wsf, qr, o0, o1, m, l, cq, r32, hi, lane);
        else {
            if (actA) tile<FOX, true>(kbA, vbA, ckbA, (const ALDS float*)nullptr, wsf, qr, o0, o1, m, l, carry, cq, tA, qrow, r32, hi, lane, tf, ones);
            if (actB) { if (tB * 64 + 63 >= R) tile<FOX, true>(kbB, vbB, ckbB, (const ALDS float*)nullptr, wsf, qr, o0, o1, m, l, carry, cq, tB, qrow, r32, hi, lane, tf, ones);
                        else tile<FOX, false>(kbB, vbB, ckbB, (const ALDS float*)nullptr, wsf, qr, o0, o1, m, l, carry, cq, tB, qrow, r32, hi, lane, tf, ones); }
        }
        if (lane == 0) flags[pb * 8 + wid] = wdone ? 1u : 0u;
        if (j + 1 < npairs) FX_WRITE(pb ^ 1);
        __syncthreads();
        { unsigned all = 1u;
#pragma unroll
          for (int w = 0; w < 8; ++w) all &= flags[pb * 8 + w];
          if (all) break; }
    }
#undef FX_LOAD
#undef FX_WRITE
    const float lt = l + __shfl_xor(l, 32); const float rl = 1.0f / lt;
    if (hi == 0) wsf[r32] = rl;
    float fr[16];
#pragma unroll
    for (int r = 0; r < 16; ++r) fr[r] = wsf[crow(r, hi)];
    __hip_bfloat16* Ob = (__hip_bfloat16*)A.O + (rowbase + R) * 1024 + h * 64 + r32;
#pragma unroll
    for (int r = 0; r < 16; ++r) { const int row = crow(r, hi); Ob[(size_t)row * 1024] = __float2bfloat16(o0[r] * fr[r]); Ob[(size_t)row * 1024 + 32] = __float2bfloat16(o1[r] * fr[r]); }
}
template <int MODE>
__device__ __forceinline__ void attn_phase(ALDS unsigned char* lds, const AttnArgs& A, const int vcu, const int G) {
    if (MODE == FOX) {
        ALDS unsigned* qslot = (ALDS unsigned*)(lds + 131072 + 512);
        for (;;) {
            __syncthreads();
            if (tid_opaque() == 0) *qslot = atomicAdd(A.qctr, 1u);
            __syncthreads();
            const unsigned u = *qslot;
            if (u >= 2048u) break;
            const int bh = (int)(u & 127u), qb = 15 - (int)(u >> 7);
            attn_unit_fox(lds, A, bh >> 4, bh & 15, qb);
        }
        return;
    }
    for (int pi = vcu; pi < 1024; pi += G) { const int bh = pi >> 3, j = pi & 7;
        if (MODE == FOX) { attn_unit_fox(lds, A, bh >> 4, bh & 15, j); attn_unit_fox(lds, A, bh >> 4, bh & 15, 15 - j); }
        else { attn_unit_ring<MODE>(lds, A, bh >> 4, bh & 15, j); attn_unit_ring<MODE>(lds, A, bh >> 4, bh & 15, 15 - j); } }
}
}

typedef unsigned short bf16;
typedef float f32x4 __attribute__((ext_vector_type(4)));
typedef unsigned v4u __attribute__((ext_vector_type(4)));
#define LAS __attribute__((address_space(3)))
constexpr int NB = 8, SEQ = 4096, M = NB * SEQ, D = 1024, FF = 4096, PD = 256, DEPTH = 4;
constexpr int LDS_BYTES = 147456;
constexpr size_t MiB = 1u << 20;
constexpr size_t WS_W = 0;
constexpr size_t WL_STRIDE = 27 * MiB, WL_IN = 0, WL_OUT = 6 * MiB + 512 * 1024, WL_UP = WL_OUT + 2 * MiB, WL_DOWN = WL_UP + 8 * MiB, WL_PLE = WL_DOWN + 8 * MiB, WL_GATE = WL_PLE + 512 * 1024;
constexpr size_t WS_HB = 108 * MiB;
constexpr size_t WS_Q = 172 * MiB, WS_K = WS_Q + 64 * MiB, WS_V = WS_K + 64 * MiB, WS_O = WS_V + 64 * MiB;
constexpr size_t WS_A = WS_Q;
constexpr size_t WS_SCR = WS_Q;
constexpr size_t WS_PB = 428 * MiB;
constexpr size_t WS_SSQ = 450 * MiB;
constexpr size_t WS_LF = 446 * MiB, WS_CL = 448 * MiB, WS_BAR = 476 * MiB, BAR_BYTES = 16384, KMAX_OFF = 14336, QCTR_OFF = 15360, WS_END = 477 * MiB;

#define XB_TMO      128
#define XB_XCNT(j)  (256  + 64 * (j))
#define XB_XSUB(j)  (1280 + 64 * (j))
#define XB_XGEN(j)  (2304 + 64 * (j))
#define XB_TOP      3328
#define XB_TOPGEN   3392
#define XCD_BAR_WORDS 3456
#define XB_SPIN_CAP (1u << 18)

__device__ __forceinline__ unsigned xb_ld(unsigned* p)              { return __hip_atomic_load(p, __ATOMIC_RELAXED, __HIP_MEMORY_SCOPE_AGENT); }
__device__ __forceinline__ unsigned xb_add(unsigned* p, unsigned v) { return __hip_atomic_fetch_add(p, v, __ATOMIC_RELAXED, __HIP_MEMORY_SCOPE_AGENT); }
__device__ __forceinline__ unsigned xb_xcc_id() { return (unsigned)__builtin_amdgcn_s_getreg((3 << 11) | 20) & 0xFu; }
#define XB_SPIN(cond, bar) do { unsigned _sp = 0; while (cond) { __builtin_amdgcn_s_sleep(1); \
    if ((++_sp & 255u) == 0u) { if (xb_ld(&(bar)[XB_TMO])) break; if (_sp > XB_SPIN_CAP) { atomicAdd(&(bar)[XB_TMO], 1u); break; } } } } while (0)

struct XcdBarrier {
    unsigned* bar; unsigned x;
    volatile LAS unsigned* st;
};

__device__ __forceinline__ XcdBarrier xcd_barrier_post(unsigned* bar, volatile LAS unsigned* st) {
    XcdBarrier b; b.bar = bar; b.x = xb_xcc_id(); b.st = st;
    if (threadIdx.x == 0) (void)xb_add(&bar[XB_XCNT(b.x)], 1u);
    return b;
}
__device__ __forceinline__ void xcd_barrier_complete(unsigned* bar, unsigned x, unsigned& nloc, unsigned& nx) {
    const unsigned G = gridDim.x * gridDim.y * gridDim.z;
    unsigned sum, cnt, mine, sp = 0u;
    for (;;) {
        sum = 0u; cnt = 0u; mine = 0u;
#pragma unroll
        for (unsigned j = 0; j < 16; ++j) { const unsigned c = xb_ld(&bar[XB_XCNT(j)]); sum += c; cnt += (c > 0u) ? 1u : 0u; mine = (j == x) ? c : mine; }
        if (sum == G) break;
        __builtin_amdgcn_s_sleep(1);
        if ((++sp & 255u) == 0u) { if (xb_ld(&bar[XB_TMO])) break; if (sp > XB_SPIN_CAP) { atomicAdd(&bar[XB_TMO], 1u); break; } }
    }
    nloc = mine > 0u ? mine : 1u; nx = cnt > 0u ? cnt : 1u;
}

__device__ __forceinline__ void xcd_barrier(const XcdBarrier& b) {
    asm volatile("s_waitcnt vmcnt(0)" ::: "memory");
    __syncthreads();
    if (threadIdx.x == 0) {
        unsigned* bar = b.bar;
        __builtin_amdgcn_s_waitcnt(0);
        unsigned nloc = b.st[0], nx = b.st[1];
        if (nloc == 0u) { xcd_barrier_complete(bar, b.x, nloc, nx); b.st[0] = nloc; b.st[1] = nx; }
        const unsigned old = xb_add(&bar[XB_XSUB(b.x)], 1u);
        const unsigned gen = old / nloc;
        if (old + 1u == (gen + 1u) * nloc) {
            __builtin_amdgcn_fence(__ATOMIC_RELEASE, "agent");
            asm volatile("s_waitcnt vmcnt(0)" ::: "memory");
            const unsigned og = xb_add(&bar[XB_TOP], 1u);
            const unsigned tg = og / nx;
            if (og + 1u == (tg + 1u) * nx) xb_add(&bar[XB_TOPGEN], 1u);
            else XB_SPIN(xb_ld(&bar[XB_TOPGEN]) == tg, bar);
            __builtin_amdgcn_fence(__ATOMIC_ACQUIRE, "agent");
            xb_add(&bar[XB_XGEN(b.x)], 1u);
            asm volatile("s_waitcnt vmcnt(0)" ::: "memory");
        } else {
            XB_SPIN(xb_ld(&bar[XB_XGEN(b.x)]) == gen, bar);
            __builtin_amdgcn_fence(__ATOMIC_ACQUIRE, "agent");
            asm volatile("s_waitcnt vmcnt(0)" ::: "memory");
        }
    }
    __syncthreads();
}

struct Args { const float* in[19]; float* out; unsigned char* ws; };

__device__ __forceinline__ unsigned f2bf(float f) { unsigned u = __builtin_bit_cast(unsigned, f); return (u + 0x7fffu + ((u >> 16) & 1u)) >> 16; }
__device__ __forceinline__ unsigned pk2(float lo, float hi) { return f2bf(lo) | (f2bf(hi) << 16); }
__device__ __forceinline__ float wave_sum(float v) {
#pragma unroll
    for (int o = 1; o < 64; o <<= 1) v += __shfl_xor(v, o);
    return v;
}
__device__ __forceinline__ void transpose_item(const float* W, int K, int ld, int Nvalid, int Npad, const float* gain, bf16* WT, LAS float* scr, int item, int lane) {
    const int nblk = Npad / 32, kb = item / nblk, nb = item % nblk, k0 = 64 * kb, n0 = 32 * nb;
    const int c = n0 + (lane & 31);
#pragma unroll 8
    for (int i = 0; i < 32; ++i) { const int kk = 2 * i + (lane >> 5); float v = 0.f; if (c < Nvalid) { v = W[(size_t)(k0 + kk) * ld + c]; if (gain) v *= gain[k0 + kk]; } scr[kk * 33 + (lane & 31)] = v; }
    asm volatile("s_waitcnt lgkmcnt(0)" ::: "memory");
    const int ch = lane & 7;
#pragma unroll
    for (int j = 0; j < 4; ++j) { const int n = (lane >> 3) + 8 * j; const LAS float* s = scr + (8 * ch) * 33 + n;
        v4u o; o.x = pk2(s[0 * 33], s[1 * 33]); o.y = pk2(s[2 * 33], s[3 * 33]); o.z = pk2(s[4 * 33], s[5 * 33]); o.w = pk2(s[6 * 33], s[7 * 33]);
        *(v4u*)(WT + (size_t)(n0 + n) * K + k0 + 8 * ch) = o; }
    asm volatile("s_waitcnt lgkmcnt(0)" ::: "memory");
}
__device__ __forceinline__ void transpose_mat(const float* W, int K, int ld, int Nvalid, int Npad, const float* gain, bf16* WT, LAS float* scr, int gw, int NGW, int lane) {
    const int nitems = (K / 64) * (Npad / 32);
    for (int it = gw; it < nitems; it += NGW) transpose_item(W, K, ld, Nvalid, Npad, gain, WT, scr, it, lane);
}

#define GRID_SYNC() do { asm volatile("s_waitcnt vmcnt(0) lgkmcnt(0)" ::: "memory"); grid.sync(); asm volatile("buffer_inv sc1\n\ts_waitcnt vmcnt(0)" ::: "memory"); } while (0)
__device__ __forceinline__ void transpose_mat_wg(const float* W, int K, int ld, int Nvalid, int Npad, const float* gain, bf16* WT, LAS float* tile, int wg, int nwg, int tid) {
    const int nblk = Npad >> 6, nitems = (K >> 6) * nblk;
    const int lr = tid >> 4, lc = (tid & 15) * 4, n = tid & 63, c = __builtin_amdgcn_readfirstlane(tid >> 6);
    int it = wg; if (it >= nitems) return;
    f32x4 v0, v1;
#define TR_LOAD(item) do { const int kb_ = (item) / nblk, nb_ = (item) - kb_ * nblk; const int col_ = (nb_ << 6) + lc; const float* src_ = W + (size_t)((kb_ << 6) + lr) * ld + col_; \
        if (col_ < Nvalid) { v0 = *(const f32x4*)src_; v1 = *(const f32x4*)(src_ + (size_t)32 * ld); } else { v0 = (f32x4){0.f, 0.f, 0.f, 0.f}; v1 = v0; } } while (0)
    TR_LOAD(it);
    for (;;) {
        const int kb = it / nblk, nb = it - kb * nblk, k0 = kb << 6, n0 = nb << 6;
        __syncthreads();
        *(LAS f32x4*)(tile + lr * 68 + lc) = v0; *(LAS f32x4*)(tile + (lr + 32) * 68 + lc) = v1;
        __syncthreads();
        const int nxt = it + nwg; const bool more = nxt < nitems;
        if (more) TR_LOAD(nxt);
        float t[8];
#pragma unroll
        for (int j = 0; j < 8; ++j) { t[j] = tile[(8 * c + j) * 68 + n]; if (gain) t[j] *= gain[k0 + 8 * c + j]; }
        v4u o; o.x = pk2(t[0], t[1]); o.y = pk2(t[2], t[3]); o.z = pk2(t[4], t[5]); o.w = pk2(t[6], t[7]);
        *(v4u*)(WT + (size_t)(n0 + n) * K + k0 + 8 * c) = o;
        if (!more) break;
        it = nxt;
    }
#undef TR_LOAD
}

__global__ void __launch_bounds__(512, 2) mega_fwd(Args args) {
    extern __shared__ __attribute__((aligned(16))) unsigned char lds_raw[];
    cg::grid_group grid = cg::this_grid();
    LAS unsigned char* lds = (LAS unsigned char*)lds_raw;
    const int G = gridDim.x, bx = blockIdx.x; const int vcu = (G % 8 == 0) ? (bx % 8) * (G / 8) + bx / 8 : bx;
    const int NGW = G * 8, NGT = G * 512;
#define tid tid_opaque()
#define lane (tid_opaque() & 63)
#define wave __builtin_amdgcn_readfirstlane(tid_opaque() >> 6)
#define gw (vcu * 8 + wave)
#define gt (bx * 512 + tid_opaque())
    unsigned char* ws = args.ws;
    { volatile LAS unsigned* misc = (volatile LAS unsigned*)(lds + 131072); if (tid < 32) misc[tid] = 0u; }
    __syncthreads();
    const XcdBarrier xbar = xcd_barrier_post((unsigned*)(ws + WS_BAR), (volatile LAS unsigned*)(lds + 131072));
#define OPQ(p_) ({ auto q_ = (p_); asm volatile("" : "+s"(q_)); q_; })
#define OPQ0() ({ int z_ = 0; asm volatile("" : "+s"(z_)); z_; })
#define KIN(k_) (args.in[k_] + OPQ0())
#define WSP(off_) (ws + (size_t)(off_) + OPQ0())
#define XIN KIN(0)
#define PIN KIN(1)
#define attn_norm KIN(2)
#define mlp_norm KIN(3)
#define ple_norm KIN(4)
#define final_norm KIN(5)
#define w_in_sb KIN(6)
#define w_out_sb KIN(7)
#define w_in_fox KIN(8)
#define b_forget KIN(9)
#define w_out_fox KIN(10)
#define w_in_swa KIN(11)
#define sinks KIN(12)
#define w_out_swa KIN(13)
#define rel_bias KIN(14)
#define w_up KIN(15)
#define w_down KIN(16)
#define w_ple KIN(17)
#define w_gate KIN(18)
#define hout (args.out + OPQ0())
#define HB0 ((bf16*)WSP(WS_HB))
#define HB1 ((bf16*)(args.out + OPQ0()))
#define HBF ((bf16*)WSP(WS_O))
#define QB ((bf16*)WSP(WS_Q))
#define KB ((bf16*)WSP(WS_K))
#define VB ((bf16*)WSP(WS_V))
#define OB ((bf16*)WSP(WS_O))
#define AB ((bf16*)WSP(WS_A))
#define SCR ((float*)WSP(WS_SCR))
#define PB ((bf16*)WSP(WS_PB))
#define SSQ ((float*)WSP(WS_SSQ))
#define LF ((float*)WSP(WS_LF))
#define CL ((float*)WSP(WS_CL))

    { const float* xin = XIN; bf16* hb1 = HB1; float* ssq0 = SSQ; const int ln = lane, gw0 = gw;
      for (int mrow = gw0; mrow < M; mrow += 2 * NGW) {
        const int mrow2 = (mrow + NGW < M) ? mrow + NGW : mrow;
        const f32x4* xr = (const f32x4*)(xin + (size_t)mrow * D) + ln; const f32x4* xr2 = (const f32x4*)(xin + (size_t)mrow2 * D) + ln;
        f32x4 v[4], w[4];
#pragma unroll
        for (int j = 0; j < 4; ++j) { v[j] = xr[64 * j]; w[j] = xr2[64 * j]; }
        unsigned long long* o8 = (unsigned long long*)(hb1 + (size_t)mrow * D) + ln; unsigned long long* o82 = (unsigned long long*)(hb1 + (size_t)mrow2 * D) + ln;
        float s1 = 0.f, s2 = 0.f;
#pragma unroll
        for (int j = 0; j < 4; ++j) { s1 += (v[j].x * v[j].x + v[j].y * v[j].y) + (v[j].z * v[j].z + v[j].w * v[j].w); s2 += (w[j].x * w[j].x + w[j].y * w[j].y) + (w[j].z * w[j].z + w[j].w * w[j].w);
            o8[64 * j] = (unsigned long long)pk2(v[j].x, v[j].y) | ((unsigned long long)pk2(v[j].z, v[j].w) << 32);
            o82[64 * j] = (unsigned long long)pk2(w[j].x, w[j].y) | ((unsigned long long)pk2(w[j].z, w[j].w) << 32); }
        s1 = wave_sum(s1); s2 = wave_sum(s2);
        if (ln == 0) { f32x4* sp = (f32x4*)(ssq0 + (size_t)mrow * 16); sp[0] = (f32x4){s1, 0.f, 0.f, 0.f}; sp[1] = (f32x4){0.f, 0.f, 0.f, 0.f}; sp[2] = (f32x4){0.f, 0.f, 0.f, 0.f}; sp[3] = (f32x4){0.f, 0.f, 0.f, 0.f};
                       f32x4* sq = (f32x4*)(ssq0 + (size_t)mrow2 * 16); sq[0] = (f32x4){s2, 0.f, 0.f, 0.f}; sq[1] = (f32x4){0.f, 0.f, 0.f, 0.f}; sq[2] = (f32x4){0.f, 0.f, 0.f, 0.f}; sq[3] = (f32x4){0.f, 0.f, 0.f, 0.f}; }
      } }
    {
        LAS float* scr = (LAS float*)lds;
#pragma unroll 1
        for (int i = 0; i < DEPTH; ++i) {
            const int kind = i % 3, j = i / 3; unsigned char* wl = ws + WS_W + (size_t)i * WL_STRIDE;
            if (kind == 0) transpose_mat_wg(w_in_sb + (size_t)j * D * 3072, D, 3072, 3072, 3072, attn_norm + i * D, (bf16*)(wl + WL_IN), scr, vcu, G, tid);
            else if (kind == 1) transpose_mat_wg(w_in_fox, D, 3088, 3088, 3328, attn_norm + i * D, (bf16*)(wl + WL_IN), scr, vcu, G, tid);
            else transpose_mat_wg(w_in_swa, D, 1536, 1536, 1536, attn_norm + i * D, (bf16*)(wl + WL_IN), scr, vcu, G, tid);
            const float* wo = kind == 0 ? w_out_sb + (size_t)j * D * D : (kind == 1 ? w_out_fox : w_out_swa);
            transpose_mat_wg(wo, D, D, D, D, nullptr, (bf16*)(wl + WL_OUT), scr, vcu, G, tid);
            transpose_mat_wg(w_up + (size_t)i * D * FF, D, FF, FF, FF, mlp_norm + i * D, (bf16*)(wl + WL_UP), scr, vcu, G, tid);
            transpose_mat_wg(w_down + (size_t)i * FF * D, FF, D, D, D, nullptr, (bf16*)(wl + WL_DOWN), scr, vcu, G, tid);
            transpose_mat_wg(w_ple + (size_t)i * PD * D, PD, D, D, D, nullptr, (bf16*)(wl + WL_PLE), scr, vcu, G, tid);
            transpose_mat_wg(w_gate + (size_t)i * D * D, D, D, D, D, ple_norm + i * D, (bf16*)(wl + WL_GATE), scr, vcu, G, tid);
        }
    }
    __syncthreads();
    GRID_SYNC();

    const float C2 = 0.125f * 1.4426950408889634f;
#pragma unroll 1
    for (int i = 0; i < DEPTH; ++i) {
        const int kind = i % 3; unsigned char* wl = ws + WS_W + (size_t)i * WL_STRIDE;
        bf16* hb_next = (i == DEPTH - 1) ? HBF : HB1;
        { const f32x4* ps = (const f32x4*)(PIN + (size_t)i * M * PD); unsigned long long* pd = (unsigned long long*)PB; const int gt0 = gt;
          for (int e = gt0; e < M * PD / 4; e += 4 * NGT) {
              f32x4 v4[4];
#pragma unroll
              for (int q = 0; q < 4; ++q) { const int idx = (e + q * NGT < M * PD / 4) ? e + q * NGT : e; v4[q] = ps[idx]; }
#pragma unroll
              for (int q = 0; q < 4; ++q) { const int idx = (e + q * NGT < M * PD / 4) ? e + q * NGT : e; pd[idx] = (unsigned long long)pk2(v4[q].x, v4[q].y) | ((unsigned long long)pk2(v4[q].z, v4[q].w) << 32); } } }
        {
            const int N = kind == 0 ? 3072 : (kind == 1 ? 3328 : 1536);
            pg8::Gemm g{HB1, (const bf16*)(wl + WL_IN), M, N, D}; pg8::StaticOrder S; S.init(M, N, G, bx);
            epi::EpiQkv E{SSQ + (size_t)(3 * i) * M * 16, QB, KB, VB, kind == 2 ? 1 : 4, kind == 2 ? 256 : 1024, C2, LF, b_forget};
#ifndef X_NOQKV
            epi::fill_rstd(E.ssq, S);
            pg8::gemm_phase<epi::EpiQkv, pg8::StaticOrder, true, true>(lds, g, S, E);
#endif
        }
        xcd_barrier(xbar);
        if (kind == 1) {
            { const float* lf0 = LF; float* cl0 = CL; const int ln = lane, gw0 = gw;
              for (int seq = gw0; seq < NB * 16; seq += NGW) { const int b = seq >> 4, h = seq & 15;
                const float* src = lf0 + ((size_t)b * SEQ + 4 * ln) * 16 + h; float* dst = cl0 + (size_t)seq * SEQ + 4 * ln;
                float v[16][4];
#pragma unroll
                for (int c = 0; c < 16; ++c)
#pragma unroll
                    for (int i = 0; i < 4; ++i) v[c][i] = src[(size_t)(c * 256 + i) * 16];
                float carry = 0.f;
#pragma unroll
                for (int c = 0; c < 16; ++c) {
                    const float a1 = v[c][0] + v[c][1], a2 = a1 + v[c][2], a3 = a2 + v[c][3];
                    float incl = a3;
#pragma unroll
                    for (int o = 1; o < 64; o <<= 1) { const float t = __shfl_up(incl, o); if (ln >= o) incl += t; }
                    const float base = carry + (incl - a3);
                    f32x4 outv = {base + v[c][0], base + a1, base + a2, base + a3};
                    *(f32x4*)(dst + c * 256) = outv * 1.4426950408889634f;
                    carry = __shfl(base + a3, 63);
                } }
              { const bf16* kb0 = KB; unsigned* km = (unsigned*)(WSP(WS_BAR) + KMAX_OFF);
                for (int seg = gw0; seg < NB * 16 * 16; seg += NGW) { const int bh = seg >> 4, part = seg & 15; const int b = bh >> 4, h = bh & 15;
                    const bf16* kp = kb0 + ((size_t)b * SEQ + part * 256 + 4 * ln) * 1024 + h * 64; float best = 0.f;
#pragma unroll
                    for (int r = 0; r < 4; ++r) { float ss = 0.f;
#pragma unroll
                        for (int c = 0; c < 8; ++c) { const v4u w = *(const v4u*)(kp + (size_t)r * 1024 + c * 8);
#pragma unroll
                            for (int e = 0; e < 4; ++e) { const float lo = __uint_as_float(w[e] << 16), hi2 = __uint_as_float(w[e] & 0xffff0000u); ss += lo * lo + hi2 * hi2; } }
                        best = fmaxf(best, ss); }
#pragma unroll
                    for (int o = 1; o < 64; o <<= 1) best = fmaxf(best, __shfl_xor(best, o));
                    if (ln == 0) atomicMax(km + bh, __float_as_uint(best)); } } }
            xcd_barrier(xbar);
        }
        {
            att::AttnArgs A{QB, KB, VB, OB, kind == 2 ? 256 : 1024, CL, rel_bias, sinks, (const unsigned*)(WSP(WS_BAR) + KMAX_OFF), (unsigned*)(WSP(WS_BAR) + QCTR_OFF)};
#ifndef X_NOSB
            if (kind == 0) att::attn_phase<att::SB>(lds, A, vcu, G);
#endif
#ifndef X_NOFOX
            if (kind == 1) att::attn_phase<att::FOX>(lds, A, vcu, G);
#endif
#ifndef X_NOSWA
            if (kind == 2) att::attn_phase<att::SWA>(lds, A, vcu, G);
#endif
        }
        xcd_barrier(xbar);
        {
            pg8::Gemm g{OB, (const bf16*)(wl + WL_OUT), M, D, D}; pg8::StaticOrder S; S.init(M, D, G, bx);
            epi::EpiRes<0> E{HB1, HB0, SSQ + (size_t)(3 * i + 1) * M * 16, nullptr, nullptr};
#ifndef X_NORES1
            pg8::gemm_phase<epi::EpiRes<0>, pg8::StaticOrder, true, true>(lds, g, S, E);
#endif
        }
        xcd_barrier(xbar);
        {
            pg8::Gemm g{HB0, (const bf16*)(wl + WL_UP), M, FF, D}; pg8::StaticOrder S; S.init(M, FF, G, bx);
            epi::EpiAct<1> E{SSQ + (size_t)(3 * i + 1) * M * 16, AB, FF};
#ifndef X_NOUP
            epi::fill_rstd(E.ssq, S);
            pg8::gemm_phase<epi::EpiAct<1>, pg8::StaticOrder, true, true>(lds, g, S, E);
#endif
        }
        xcd_barrier(xbar);
        {
            pg8::Gemm g{AB, (const bf16*)(wl + WL_DOWN), M, D, FF}; pg8::StaticOrder S; S.init(M, D, G, bx);
            epi::EpiRes<0> E{HB0, HB0, SSQ + (size_t)(3 * i + 2) * M * 16, nullptr, nullptr};
#ifndef X_NORES2
            pg8::gemm_phase<epi::EpiRes<0>, pg8::StaticOrder, true, true>(lds, g, S, E);
#endif
        }
        xcd_barrier(xbar);
        {
            int Kp = PD; asm volatile("" : "+s"(Kp));
            pg8::Gemm g{PB, (const bf16*)(wl + WL_PLE), M, D, Kp}; pg8::StaticOrder S; S.init(M, D, G, bx);
            epi::EpiDump E{SCR};
#ifndef X_NODUMP
            pg8::gemm_phase<epi::EpiDump, pg8::StaticOrder, true, true>(lds, g, S, E);
#endif
        }
        {
            pg8::Gemm g{HB0, (const bf16*)(wl + WL_GATE), M, D, D}; pg8::StaticOrder S; S.init(M, D, G, bx);
            epi::EpiRes<1> E{HB0, hb_next, SSQ + (size_t)(3 * i + 3) * M * 16, SSQ + (size_t)(3 * i + 2) * M * 16, SCR};
#ifndef X_NOGATE
            epi::fill_rstd(E.ssq_in, S);
            pg8::gemm_phase<epi::EpiRes<1>, pg8::StaticOrder, true, true>(lds, g, S, E);
#endif
        }
        xcd_barrier(xbar);
    }
    const float* ssqF = SSQ + (size_t)12 * M * 16; const bf16* hbf = HBF; float* outp = hout; const float* fng = final_norm; const int lnF = lane, gwF = gw;
    for (int mrow = gwF; mrow < M; mrow += 2 * NGW) {
        const int mrow2 = (mrow + NGW < M) ? mrow + NGW : mrow;
        const float rs = epi::rstd_of(ssqF, mrow), rs2 = epi::rstd_of(ssqF, mrow2);
        const unsigned long long* hr = (const unsigned long long*)(hbf + (size_t)mrow * D) + lnF; const unsigned long long* hr2 = (const unsigned long long*)(hbf + (size_t)mrow2 * D) + lnF;
        f32x4* orow = (f32x4*)(outp + (size_t)mrow * D) + lnF; f32x4* orow2 = (f32x4*)(outp + (size_t)mrow2 * D) + lnF; const f32x4* gr = (const f32x4*)fng + lnF;
        unsigned long long w1[4], w2[4]; f32x4 g[4];
#pragma unroll
        for (int j = 0; j < 4; ++j) { w1[j] = hr[64 * j]; w2[j] = hr2[64 * j]; g[j] = gr[64 * j]; }
#pragma unroll
        for (int j = 0; j < 4; ++j) {
            { const unsigned lo = (unsigned)w1[j], hi2 = (unsigned)(w1[j] >> 32); const f32x4 v = {__uint_as_float(lo << 16), __uint_as_float(lo & 0xffff0000u), __uint_as_float(hi2 << 16), __uint_as_float(hi2 & 0xffff0000u)}; orow[64 * j] = v * rs * g[j]; }
            { const unsigned lo = (unsigned)w2[j], hi2 = (unsigned)(w2[j] >> 32); const f32x4 v = {__uint_as_float(lo << 16), __uint_as_float(lo & 0xffff0000u), __uint_as_float(hi2 << 16), __uint_as_float(hi2 & 0xffff0000u)}; orow2[64 * j] = v * rs2 * g[j]; } }
    }
}

#undef tid
#undef lane
#undef wave
#undef gw
#undef gt
#undef XIN
#undef PIN
#undef attn_norm
#undef mlp_norm
#undef ple_norm
#undef final_norm
#undef w_in_sb
#undef w_out_sb
#undef w_in_fox
#undef b_forget
#undef w_out_fox
#undef w_in_swa
#undef sinks
#undef w_out_swa
#undef rel_bias
#undef w_up
#undef w_down
#undef w_ple
#undef w_gate
#undef hout
#undef HB0
#undef HB1
#undef HBF
#undef QB
#undef KB
#undef VB
#undef OB
#undef AB
#undef SCR
#undef PB
#undef SSQ
#undef LF
#undef CL
extern "C" void kernel_launch(void* const* d_in, const int* in_sizes, int n_in, void* d_out, int out_size, void* d_ws, size_t ws_size, hipStream_t stream) {
    static int grid = 0;
    if (grid == 0) {
        if (n_in != 19 || out_size != M * D || ws_size < WS_END) { fprintf(stderr, "kernel_launch: unexpected shapes (n_in %d out %d ws %zu)\n", n_in, out_size, ws_size); grid = -1; return; }
        int dev = 0, cus = 0, per_cu = 0;
        (void)hipGetDevice(&dev);
        (void)hipDeviceGetAttribute(&cus, hipDeviceAttributeMultiprocessorCount, dev);
        if (hipFuncSetAttribute((const void*)mega_fwd, hipFuncAttributeMaxDynamicSharedMemorySize, LDS_BYTES) != hipSuccess) fprintf(stderr, "kernel_launch: hipFuncSetAttribute failed\n");
        if (hipOccupancyMaxActiveBlocksPerMultiprocessor(&per_cu, (const void*)mega_fwd, 512, LDS_BYTES) != hipSuccess || per_cu < 1) { fprintf(stderr, "kernel_launch: occupancy query gave %d\n", per_cu); per_cu = 1; }
        (void)hipGetLastError();
        grid = cus;
    }
    if (grid < 0) return;
    if (hipMemsetAsync((unsigned char*)d_ws + WS_BAR, 0, BAR_BYTES, stream) != hipSuccess) { fprintf(stderr, "kernel_launch: memset of the barrier words failed\n"); return; }
    Args a{};
    for (int i = 0; i < 19; ++i) a.in[i] = (const float*)d_in[i];
    a.out = (float*)d_out; a.ws = (unsigned char*)d_ws;
    void* kargs[] = {&a};
    const hipError_t e = hipLaunchCooperativeKernel((const void*)mega_fwd, dim3(grid), dim3(512), kargs, LDS_BYTES, stream);
    if (e != hipSuccess) fprintf(stderr, "kernel_launch: cooperative launch failed: %s (grid %d)\n", hipGetErrorString(e), grid);
}
```
